# Optimizing an MI355X kernel written in HIP

```python
import math
import jax, jax.numpy as jnp
from jax import lax
import numpy as np

D_MODEL = 4096
BATCH = 4
SEQ = 4096
DEPTH = 1

CHUNK = 64

FOX_HEADS = 16
FOX_HEAD_DIM = 128
FOX_WIDTH = FOX_HEADS * FOX_HEAD_DIM
Q_BLOCK = 128

S5_GROUP = 16
S5_GROUPS = 64
S5_WIDTH = S5_GROUP * S5_GROUPS
S5_STATE = 64

D_FF = ((8 * D_MODEL + 3 * 256 - 1) // (3 * 256)) * 256

N_BRANCHES = 2
RMS_EPS = 1e-6
MASK_VALUE = -1e30

COL_Q = FOX_WIDTH
COL_K = COL_Q + FOX_WIDTH
COL_V = COL_K + FOX_WIDTH
COL_F = COL_V + FOX_HEADS
COL_S5 = COL_F + S5_WIDTH
COL_GATE_FOX = COL_S5 + D_MODEL
IN_COLS = COL_GATE_FOX + D_MODEL

kernel_name = "fox_s5_gated_hybrid_block"


def _rmsnorm(x, g):
    x32 = x.astype(jnp.float32)
    y = x32 * lax.rsqrt(jnp.mean(x32 * x32, axis=-1, keepdims=True) + RMS_EPS)
    return (y * g.astype(jnp.float32)).astype(x.dtype)


def _forgetting_attention(q, k, v, f_logit, q_norm, k_norm):
    B, S, _ = q.shape
    n_blk = S // Q_BLOCK
    q = _rmsnorm(q.reshape(B, S, FOX_HEADS, FOX_HEAD_DIM), q_norm) * (1.0 / math.sqrt(FOX_HEAD_DIM))
    k = _rmsnorm(k.reshape(B, S, FOX_HEADS, FOX_HEAD_DIM), k_norm)
    v = v.reshape(B, S, FOX_HEADS, FOX_HEAD_DIM)
    qh = q.transpose(0, 2, 1, 3)
    kh = k.transpose(0, 2, 1, 3)
    vh = v.transpose(0, 2, 1, 3)
    log_f = jax.nn.log_sigmoid(f_logit.astype(jnp.float32))
    F = jnp.cumsum(log_f, axis=1).transpose(0, 2, 1)
    q_blocks = qh.reshape(B, FOX_HEADS, n_blk, Q_BLOCK, FOX_HEAD_DIM).transpose(2, 0, 1, 3, 4)
    f_blocks = F.reshape(B, FOX_HEADS, n_blk, Q_BLOCK).transpose(2, 0, 1, 3)
    k_pos = jnp.arange(S)

    def one_block(args):
        qb, fb, blk = args
        q_pos = blk * Q_BLOCK + jnp.arange(Q_BLOCK)
        logits = jnp.einsum('bhqd,bhkd->bhqk', qb, kh).astype(jnp.float32)
        logits = logits + (fb[..., :, None] - F[:, :, None, :])
        logits = jnp.where(k_pos[None, :] <= q_pos[:, None], logits, MASK_VALUE)
        p = jax.nn.softmax(logits, axis=-1)
        return jnp.einsum('bhqk,bhkd->bhqd', p.astype(vh.dtype), vh)

    out = lax.map(one_block, (q_blocks, f_blocks, jnp.arange(n_blk)))
    return out.transpose(1, 0, 3, 2, 4).reshape(B, S, FOX_WIDTH)


def _cplx_scan_op(e1, e2):
    a1r, a1i, b1r, b1i = e1
    a2r, a2i, b2r, b2i = e2
    ar = a2r * a1r - a2i * a1i
    ai = a2r * a1i + a2i * a1r
    br = a2r * b1r - a2i * b1i + b2r
    bi = a2r * b1i + a2i * b1r + b2i
    return (ar, ai, br, bi)


def _s5(s5_in, lam_re, lam_im, log_step, b_re, b_im, c_re, c_im, d, w_glu, b_glu):
    B, S, _ = s5_in.shape
    u = s5_in.reshape(B, S, S5_GROUPS, S5_GROUP).astype(jnp.float32)
    lr = lam_re.astype(jnp.float32)
    li = lam_im.astype(jnp.float32)
    dt = jnp.exp(log_step.astype(jnp.float32))[:, None]
    mag = jnp.exp(lr * dt)
    lb_re = mag * jnp.cos(li * dt)
    lb_im = mag * jnp.sin(li * dt)
    denom = lr * lr + li * li
    num_re = lb_re - 1.0
    fac_re = (num_re * lr + lb_im * li) / denom
    fac_im = (lb_im * lr - num_re * li) / denom
    br = b_re.astype(jnp.float32)
    bi = b_im.astype(jnp.float32)
    bb_re = fac_re[..., None] * br - fac_im[..., None] * bi
    bb_im = fac_re[..., None] * bi + fac_im[..., None] * br
    bu_re = jnp.einsum('bsgi,gpi->bsgp', u, bb_re)
    bu_im = jnp.einsum('bsgi,gpi->bsgp', u, bb_im)
    a_re = jnp.broadcast_to(lb_re[None, None], (1, S, S5_GROUPS, S5_STATE))
    a_im = jnp.broadcast_to(lb_im[None, None], (1, S, S5_GROUPS, S5_STATE))
    _, _, x_re, x_im = lax.associative_scan(_cplx_scan_op, (a_re, a_im, bu_re, bu_im), axis=1)
    y = (jnp.einsum('bsgp,gip->bsgi', x_re, c_re.astype(jnp.float32))
         - jnp.einsum('bsgp,gip->bsgi', x_im, c_im.astype(jnp.float32))
         + d.astype(jnp.float32) * u)
    y = y.reshape(B, S, S5_WIDTH).astype(s5_in.dtype)
    g = jax.nn.gelu(y)
    return g * jax.nn.sigmoid(g @ w_glu + b_glu)


def _layer(x, g_mix, w_in, b_fgate, b_gates, q_norm, k_norm,
           s5_lambda_re, s5_lambda_im, s5_log_step, s5_b_re, s5_b_im, s5_c_re, s5_c_im, s5_d,
           w_glu, b_glu, w_proj_fox, w_proj_s5, w_out, g_ffn, w_gate_up, w_down):
    u = _rmsnorm(x, g_mix)
    z = u @ w_in
    q, k, v, f_logit, s5_in, gate_logits = jnp.split(
        z, [COL_Q, COL_K, COL_V, COL_F, COL_S5], axis=-1)
    gates = jax.nn.sigmoid(gate_logits.astype(jnp.float32) + b_gates.astype(jnp.float32))
    gate_fox, gate_s5 = jnp.split(gates, [D_MODEL], axis=-1)
    attn = _forgetting_attention(q, k, v, f_logit + b_fgate, q_norm, k_norm)
    ssm = _s5(s5_in, s5_lambda_re, s5_lambda_im, s5_log_step, s5_b_re, s5_b_im,
              s5_c_re, s5_c_im, s5_d, w_glu, b_glu)
    merged = (gate_fox * (attn @ w_proj_fox) + gate_s5 * (ssm @ w_proj_s5)).astype(x.dtype)
    h = x + merged @ w_out
    hn = _rmsnorm(h, g_ffn)
    gate, up = jnp.split(hn @ w_gate_up, [D_FF], axis=-1)
    return h + (jax.nn.silu(gate) * up) @ w_down


def _normal(key, shape, scale):
    return jax.random.normal(key, shape, jnp.float32) * scale


def setup_inputs(seed: int = 0) -> dict:
    key = jax.random.key(seed)
    ks = jax.random.split(key, 24)
    L = DEPTH
    n_idx = jnp.arange(S5_STATE, dtype=jnp.float32)
    lam_re = -0.5 + _normal(ks[8], (L, S5_GROUPS, S5_STATE), 0.01)
    lam_im = math.pi * n_idx[None, None, :] + _normal(ks[9], (L, S5_GROUPS, S5_STATE), 0.01)
    log_step = jax.random.uniform(ks[10], (L, S5_GROUPS), jnp.float32,
                                  math.log(1e-3), math.log(1e-1))
    return {
        "x": _normal(ks[0], (BATCH, SEQ, D_MODEL), 1.0),
        "g_mix": 1.0 + _normal(ks[1], (L, D_MODEL), 0.02),
        "w_in": _normal(ks[2], (L, D_MODEL, IN_COLS), D_MODEL ** -0.5),
        "b_fgate": 3.0 + _normal(ks[3], (L, FOX_HEADS), 0.5),
        "b_gates": _normal(ks[4], (L, N_BRANCHES * D_MODEL), 0.02),
        "q_norm": 1.0 + _normal(ks[5], (L, FOX_HEAD_DIM), 0.02),
        "k_norm": 1.0 + _normal(ks[6], (L, FOX_HEAD_DIM), 0.02),
        "s5_lambda_re": lam_re,
        "s5_lambda_im": lam_im,
        "s5_log_step": log_step,
        "s5_b_re": _normal(ks[11], (L, S5_GROUPS, S5_STATE, S5_GROUP), (2 * S5_GROUP) ** -0.5),
        "s5_b_im": _normal(ks[12], (L, S5_GROUPS, S5_STATE, S5_GROUP), (2 * S5_GROUP) ** -0.5),
        "s5_c_re": _normal(ks[13], (L, S5_GROUPS, S5_GROUP, S5_STATE), S5_STATE ** -0.5),
        "s5_c_im": _normal(ks[14], (L, S5_GROUPS, S5_GROUP, S5_STATE), S5_STATE ** -0.5),
        "s5_d": _normal(ks[15], (L, S5_GROUPS, S5_GROUP), 1.0),
        "w_glu": _normal(ks[16], (L, S5_WIDTH, S5_WIDTH), S5_WIDTH ** -0.5),
        "b_glu": _normal(ks[17], (L, S5_WIDTH), 0.02),
        "w_proj_fox": _normal(ks[18], (L, FOX_WIDTH, D_MODEL), FOX_WIDTH ** -0.5),
        "w_proj_s5": _normal(ks[19], (L, S5_WIDTH, D_MODEL), S5_WIDTH ** -0.5),
        "w_out": _normal(ks[20], (L, D_MODEL, D_MODEL), D_MODEL ** -0.5),
        "g_ffn": 1.0 + _normal(ks[21], (L, D_MODEL), 0.02),
        "w_gate_up": _normal(ks[22], (L, D_MODEL, 2 * D_FF), D_MODEL ** -0.5),
        "w_down": _normal(ks[23], (L, D_FF, D_MODEL), D_FF ** -0.5),
    }


def reference(x, g_mix, w_in, b_fgate, b_gates, q_norm, k_norm,
              s5_lambda_re, s5_lambda_im, s5_log_step, s5_b_re, s5_b_im, s5_c_re, s5_c_im, s5_d,
              w_glu, b_glu, w_proj_fox, w_proj_s5, w_out, g_ffn, w_gate_up, w_down):
    for l in range(DEPTH):
        x = _layer(x, g_mix[l], w_in[l], b_fgate[l], b_gates[l], q_norm[l], k_norm[l],
                   s5_lambda_re[l], s5_lambda_im[l], s5_log_step[l], s5_b_re[l], s5_b_im[l],
                   s5_c_re[l], s5_c_im[l], s5_d[l], w_glu[l], b_glu[l],
                   w_proj_fox[l], w_proj_s5[l], w_out[l], g_ffn[l], w_gate_up[l], w_down[l])
    return x
```

```cpp
#include <hip/hip_runtime.h>
#include <hip/hip_bf16.h>
#include <cstdio>
#include <cstdint>
#include <cmath>
namespace pg8 {
#define PG8_LAS __attribute__((address_space(3)))
typedef unsigned short bf16_t;
typedef short bf16x8 __attribute__((ext_vector_type(8)));
typedef float f32x4 __attribute__((ext_vector_type(4)));
typedef unsigned u32x4 __attribute__((ext_vector_type(4)));
constexpr int BM = 256, BK = 64, HALF = 128, HTB = HALF * BK * 2  , STAGE_BYTES = 8 * HTB, NXCD = 8, WGM = 8;

__host__ __device__ __forceinline__ int lds_byte(int r, int c) { const int st = (r >> 4) * 2 + (c >> 5), rr = r & 15, cc = c & 31, ob = rr * 64 + cc * 2; return st * 1024 + (ob ^ (((ob >> 9) & 1) << 5)); }
__host__ __device__ __forceinline__ void stage_rc(int b, int& R, int& C) { const int st = b / 1024, sb = b % 1024, swz = sb ^ (((sb >> 9) & 1) << 5); R = (st >> 1) * 16 + swz / 64; C = (st & 1) * 32 + (swz % 64) / 2; }
__host__ __device__ __forceinline__ int perm32(int rho) { const int n = rho >> 4, i = rho & 15; return 8 * (i >> 2) + 4 * n + (i & 3); }

struct Unit { int pm, pn; };
struct Gemm { const bf16_t* A; const bf16_t* Bt; int M, N, K; };

struct StaticOrder {
    int nM, nN, nwg, G, c;
    __host__ __device__ void init(int M, int N, int G_, int c_) { nM = M / BM; nN = N / BM; nwg = nM * nN; G = G_; c = c_; }
    __host__ __device__ bool next(int i, Unit& u) const {
        const long L = (long)i * G + c; if (L >= nwg) return false;
        int wgid = (int)L; { const int q = nwg / NXCD, r = nwg % NXCD, xcd = wgid % NXCD, off = wgid / NXCD; wgid = (xcd < r ? xcd * (q + 1) : r * (q + 1) + (xcd - r) * q) + off; }
        const int nig = WGM * nN, gid = wgid / nig, fm = gid * WGM, gsz = (nM - fm) < WGM ? (nM - fm) : WGM;
        u.pm = fm + ((wgid % nig) % gsz); u.pn = (wgid % nig) / gsz; return true;
    }
    __device__ __forceinline__ void a_ready(const Unit&) const {}
    __device__ __forceinline__ void done(const Unit&) const {}
};

__device__ __forceinline__ unsigned cvt_pk_bf16(float lo, float hi) { unsigned r; asm volatile("v_cvt_pk_bf16_f32 %0, %1, %2" : "=v"(r) : "v"(lo), "v"(hi)); return r; }
typedef float f32x2 __attribute__((ext_vector_type(2)));
__device__ __forceinline__ float sigmoid_f(float x) { return __builtin_amdgcn_rcpf(1.0f + __builtin_amdgcn_exp2f(-1.4426950408889634f * x)); }
__device__ __forceinline__ float bf_lo(unsigned w) { return __uint_as_float(w << 16); }
__device__ __forceinline__ float bf_hi(unsigned w) { return __uint_as_float(w & 0xffff0000u); }
__device__ __forceinline__ u32x4 pack8(const f32x4 v0, const f32x4 v1) { u32x4 w; w.x = cvt_pk_bf16(v0[0], v0[1]); w.y = cvt_pk_bf16(v0[2], v0[3]); w.z = cvt_pk_bf16(v1[0], v1[1]); w.w = cvt_pk_bf16(v1[2], v1[3]); return w; }

struct EpiZ {
    static constexpr bool PERM = true, AFTER_DRAIN = false;
    bf16_t* QKV; bf16_t* S5IN; bf16_t* GATES; const float* rs; const float* bg;
    __device__ __forceinline__ void operator()(const f32x4 (&acc)[2][2][4][2], const Unit& u, int wr, int wc, int fr, int fq) const {
        const int row0 = u.pm * BM + wr * 64 + fr;
        bf16_t* base; int ldc, cb; bool sig = false;
        if (u.pn < 24) { base = QKV; ldc = 6144; cb = u.pn * BM; }
        else if (u.pn < 28) { base = S5IN; ldc = 1024; cb = (u.pn - 24) * BM; }
        else { base = GATES; ldc = 8192; cb = (u.pn - 28) * BM; sig = true; }
        const int col0 = cb + wc * 32 + 8 * fq;
        f32x4 bv[2][2];
#pragma unroll
        for (int bj = 0; bj < 2; ++bj)
#pragma unroll
            for (int n = 0; n < 2; ++n) bv[bj][n] = sig ? *(const f32x4*)(bg + col0 + bj * HALF + 4 * n) : (f32x4){0.f, 0.f, 0.f, 0.f};
#pragma unroll
        for (int ai = 0; ai < 2; ++ai)
#pragma unroll
            for (int m = 0; m < 4; ++m) { const int r = row0 + ai * HALF + m * 16; const float s = rs[r]; bf16_t* rowp = base + (size_t)r * ldc + col0;
#pragma unroll
                for (int bj = 0; bj < 2; ++bj) { f32x4 v0 = acc[ai][bj][m][0] * s, v1 = acc[ai][bj][m][1] * s;
                    if (sig) { v0 = v0 + bv[bj][0]; v1 = v1 + bv[bj][1];
#pragma unroll
                        for (int e = 0; e < 4; ++e) { v0[e] = sigmoid_f(v0[e]); v1[e] = sigmoid_f(v1[e]); } }
                    *(u32x4*)(rowp + bj * HALF) = pack8(v0, v1); } }
    }
};
struct EpiGlu {
    static constexpr bool PERM = true, AFTER_DRAIN = false;
    const bf16_t* G; bf16_t* O; const float* bias; int ldc;
    __device__ __forceinline__ void operator()(const f32x4 (&acc)[2][2][4][2], const Unit& u, int wr, int wc, int fr, int fq) const {
        const int row0 = u.pm * BM + wr * 64 + fr, col0 = u.pn * BM + wc * 32 + 8 * fq;
        f32x4 bv[2][2];
#pragma unroll
        for (int bj = 0; bj < 2; ++bj)
#pragma unroll
            for (int n = 0; n < 2; ++n) bv[bj][n] = *(const f32x4*)(bias + col0 + bj * HALF + 4 * n);
#pragma unroll
        for (int ai = 0; ai < 2; ++ai)
#pragma unroll
            for (int m = 0; m < 4; ++m) { const size_t off = (size_t)(row0 + ai * HALF + m * 16) * ldc + col0;
#pragma unroll
                for (int bj = 0; bj < 2; ++bj) { const u32x4 gw = *(const u32x4*)(G + off + bj * HALF);
                    f32x4 v0 = acc[ai][bj][m][0] + bv[bj][0], v1 = acc[ai][bj][m][1] + bv[bj][1];
                    v0[0] = bf_lo(gw.x) * sigmoid_f(v0[0]); v0[1] = bf_hi(gw.x) * sigmoid_f(v0[1]); v0[2] = bf_lo(gw.y) * sigmoid_f(v0[2]); v0[3] = bf_hi(gw.y) * sigmoid_f(v0[3]);
                    v1[0] = bf_lo(gw.z) * sigmoid_f(v1[0]); v1[1] = bf_hi(gw.z) * sigmoid_f(v1[1]); v1[2] = bf_lo(gw.w) * sigmoid_f(v1[2]); v1[3] = bf_hi(gw.w) * sigmoid_f(v1[3]);
                    *(u32x4*)(O + off + bj * HALF) = pack8(v0, v1); } }
    }
};
struct EpiGateMul {
    static constexpr bool PERM = true, AFTER_DRAIN = false;
    const bf16_t* gate; int ldg; const bf16_t* add; bf16_t* O; int ldc;
    __device__ __forceinline__ void operator()(const f32x4 (&acc)[2][2][4][2], const Unit& u, int wr, int wc, int fr, int fq) const {
        const int row0 = u.pm * BM + wr * 64 + fr, col0 = u.pn * BM + wc * 32 + 8 * fq;
#pragma unroll
        for (int ai = 0; ai < 2; ++ai)
#pragma unroll
            for (int m = 0; m < 4; ++m) { const int r = row0 + ai * HALF + m * 16; const size_t off = (size_t)r * ldc + col0, goff = (size_t)r * ldg + col0;
#pragma unroll
                for (int bj = 0; bj < 2; ++bj) { const u32x4 gw = *(const u32x4*)(gate + goff + bj * HALF);
                    f32x4 v0 = acc[ai][bj][m][0], v1 = acc[ai][bj][m][1];
                    v0[0] *= bf_lo(gw.x); v0[1] *= bf_hi(gw.x); v0[2] *= bf_lo(gw.y); v0[3] *= bf_hi(gw.y);
                    v1[0] *= bf_lo(gw.z); v1[1] *= bf_hi(gw.z); v1[2] *= bf_lo(gw.w); v1[3] *= bf_hi(gw.w);
                    if (add) { const u32x4 aw = *(const u32x4*)(add + off + bj * HALF);
                        v0[0] += bf_lo(aw.x); v0[1] += bf_hi(aw.x); v0[2] += bf_lo(aw.y); v0[3] += bf_hi(aw.y);
                        v1[0] += bf_lo(aw.z); v1[1] += bf_hi(aw.z); v1[2] += bf_lo(aw.w); v1[3] += bf_hi(aw.w); }
                    *(u32x4*)(O + off + bj * HALF) = pack8(v0, v1); } }
    }
};
struct EpiResid {
    static constexpr bool PERM = false, AFTER_DRAIN = false;
    const float* base; float* out; bf16_t* hb; float* hp; int ldc;
    __device__ __forceinline__ void operator()(const f32x4 (&acc)[2][2][4][2], const Unit& u, int wr, int wc, int fr, int fq) const {
        typedef unsigned u32x2v __attribute__((ext_vector_type(2)));
        const int row0 = u.pm * BM + wr * 64 + fr, col0 = u.pn * BM + wc * 32 + 4 * fq;
#pragma unroll
        for (int ai = 0; ai < 2; ++ai)
#pragma unroll
            for (int m = 0; m < 4; ++m) { const int r = row0 + ai * HALF + m * 16; const size_t off = (size_t)r * ldc + col0; float ss = 0.f;
#pragma unroll
                for (int bj = 0; bj < 2; ++bj)
#pragma unroll
                    for (int n = 0; n < 2; ++n) { const f32x4 bs = *(const f32x4*)(base + off + bj * HALF + n * 16); const f32x4 o = bs + acc[ai][bj][m][n];
                        *(f32x4*)(out + off + bj * HALF + n * 16) = o;
                        if (hb) { u32x2v w; w.x = cvt_pk_bf16(o[0], o[1]); w.y = cvt_pk_bf16(o[2], o[3]); *(u32x2v*)(hb + off + bj * HALF + n * 16) = w;
                                  ss += (o[0] * o[0] + o[1] * o[1]) + (o[2] * o[2] + o[3] * o[3]); } }
                if (hp) { ss += __shfl_xor(ss, 16); ss += __shfl_xor(ss, 32); if (fq == 0) hp[(size_t)r * 64 + u.pn * 4 + wc] = ss; } }
    }
};
struct EpiSwiGlu {
    static constexpr bool PERM = true, AFTER_DRAIN = false;
    bf16_t* O; const float* rs; int ldc;
    __device__ __forceinline__ void operator()(const f32x4 (&acc)[2][2][4][2], const Unit& u, int wr, int wc, int fr, int fq) const {
        const int row0 = u.pm * BM + wr * 64 + fr, col0 = u.pn * HALF + wc * 32 + 8 * fq;
#pragma unroll
        for (int ai = 0; ai < 2; ++ai)
#pragma unroll
            for (int m = 0; m < 4; ++m) { const int r = row0 + ai * HALF + m * 16; const float s = rs[r];
                f32x4 g0 = acc[ai][0][m][0] * s, g1 = acc[ai][0][m][1] * s; const f32x4 u0 = acc[ai][1][m][0] * s, u1 = acc[ai][1][m][1] * s;
#pragma unroll
                for (int e = 0; e < 4; ++e) { g0[e] = g0[e] * sigmoid_f(g0[e]) * u0[e]; g1[e] = g1[e] * sigmoid_f(g1[e]) * u1[e]; }
                *(u32x4*)(O + (size_t)r * ldc + col0) = pack8(g0, g1); }
    }
};

template <class Epi, class Sched, bool ALIGN_EPI = false, bool SP2 = false>
__device__ __forceinline__ void gemm_phase(PG8_LAS unsigned char* lds, const Gemm g, const Sched& S, const Epi& E) {
    const int tid = threadIdx.x, wid = __builtin_amdgcn_readfirstlane(tid >> 6), lane = tid & 63, wr = wid >> 2, wc = wid & 3, fr = lane & 15, fq = lane >> 4;
    const int K = g.K, nt = K / BK;
    unsigned voffA[2], voffB[2];
#pragma unroll
    for (int i = 0; i < 2; ++i) { int R, C; stage_rc(tid * 16 + i * 8192, R, C); const int Rb = Epi::PERM ? ((R & ~31) + perm32(R & 31)) : R;
        voffA[i] = (unsigned)(R * K + C) * 2u; voffB[i] = (unsigned)(Rb * K + C) * 2u; }
    const size_t kstep = (size_t)(BK * 2);
    const size_t hstep = (size_t)HALF * K * 2;
    const size_t tstep = 2 * hstep;
    const unsigned ldsw = (unsigned)wid * 1024u;
    const int aoff = lds_byte(wr * 64 + fr, fq * 8), boff = lds_byte(wc * 32 + fr, fq * 8);
#define PG8_SA(b, h) (((b) * 2 + (h)) * HTB)
#define PG8_SB(b, h) ((4 + (b) * 2 + (h)) * HTB)
#define PG8_STAGE(bufoff, gbase, voff) do { _Pragma("unroll") for (int _i = 0; _i < 2; ++_i) \
        __builtin_amdgcn_global_load_lds((const unsigned*)((const char*)(gbase) + (voff)[_i]), (PG8_LAS unsigned*)(lds + (bufoff) + ldsw + _i * 8192), 16, 0, 0); } while (0)
#define PG8_LDA(dst, b, h) do { _Pragma("unroll") for (int m = 0; m < 4; ++m) _Pragma("unroll") for (int k = 0; k < 2; ++k) dst[m][k] = *(const PG8_LAS bf16x8*)(lds + PG8_SA(b, h) + aoff + m * 2048 + k * 1024); } while (0)
#define PG8_LDB(dst, b, h) do { _Pragma("unroll") for (int n = 0; n < 2; ++n) _Pragma("unroll") for (int k = 0; k < 2; ++k) dst[n][k] = *(const PG8_LAS bf16x8*)(lds + PG8_SB(b, h) + boff + n * 2048 + k * 1024); } while (0)
#define PG8_MMA(ai, bj, At, Bt) do { __builtin_amdgcn_s_setprio(1); _Pragma("unroll") for (int m = 0; m < 4; ++m) _Pragma("unroll") for (int n = 0; n < 2; ++n) _Pragma("unroll") for (int k = 0; k < 2; ++k) \
        acc[ai][bj][m][n] = __builtin_amdgcn_mfma_f32_16x16x32_bf16(Bt[n][k], At[m][k], acc[ai][bj][m][n], 0, 0, 0); __builtin_amdgcn_s_setprio(0); } while (0)
#define PG8_WAIT_V(n) asm volatile("s_waitcnt vmcnt(" #n ")" ::: "memory")
#define PG8_WAIT_L(n) asm volatile("s_waitcnt lgkmcnt(" #n ")" ::: "memory")
#define PG8_BAR __builtin_amdgcn_s_barrier()
#define PG8_SCHED __builtin_amdgcn_sched_barrier(0)
    Unit cur, nxt; int ui = 0;
    if (!S.next(0, cur)) return;
    f32x4 acc[2][2][4][2];
#pragma unroll
    for (int a = 0; a < 2; ++a)
#pragma unroll
        for (int b = 0; b < 2; ++b)
#pragma unroll
            for (int m = 0; m < 4; ++m)
#pragma unroll
                for (int n = 0; n < 2; ++n) acc[a][b][m][n] = (f32x4){0.f, 0.f, 0.f, 0.f};
    bf16x8 At[4][2], B0[2][2], B1[2][2];
    const char* cA = (const char*)g.A + (size_t)cur.pm * tstep; const char* cB = (const char*)g.Bt + (size_t)cur.pn * tstep;
    S.a_ready(cur);
    if constexpr (SP2) {
        PG8_STAGE(PG8_SB(0, 0), cB, voffB); PG8_STAGE(PG8_SB(0, 1), cB + hstep, voffB); PG8_STAGE(PG8_SA(0, 0), cA, voffA); PG8_STAGE(PG8_SA(0, 1), cA + hstep, voffA);
        if (wr == 1) PG8_BAR;
        PG8_WAIT_V(2); PG8_BAR;
        PG8_STAGE(PG8_SB(1, 0), cB + kstep, voffB); PG8_STAGE(PG8_SA(1, 0), cA + kstep, voffA); PG8_STAGE(PG8_SB(1, 1), cB + hstep + kstep, voffB);
        PG8_WAIT_V(6); PG8_BAR;
    } else {
        PG8_STAGE(PG8_SB(0, 0), cB, voffB); PG8_STAGE(PG8_SA(0, 0), cA, voffA); PG8_STAGE(PG8_SB(0, 1), cB + hstep, voffB); PG8_STAGE(PG8_SA(0, 1), cA + hstep, voffA);
        if (wr == 1) PG8_BAR;
        PG8_WAIT_V(4); PG8_BAR;
        PG8_STAGE(PG8_SB(1, 0), cB + kstep, voffB); PG8_STAGE(PG8_SA(1, 0), cA + kstep, voffA); PG8_STAGE(PG8_SB(1, 1), cB + hstep + kstep, voffB);
        PG8_WAIT_V(6); PG8_BAR;
    }
    for (;;) {
        const bool has_next = S.next(ui + 1, nxt);
        const char* nA = has_next ? (const char*)g.A + (size_t)nxt.pm * tstep : cA; const char* nB = has_next ? (const char*)g.Bt + (size_t)nxt.pn * tstep : cB;
        for (int t = 0; t < nt; t += 2) {
            const bool last = (t == nt - 2);
            const char* a1 = cA + (size_t)(t + 1) * kstep;
            const char* a2 = last ? nA : cA + (size_t)(t + 2) * kstep; const char* b2 = last ? nB : cB + (size_t)(t + 2) * kstep;
            const char* a3 = a2 + kstep; const char* b3 = b2 + kstep;
            if (last && has_next) S.a_ready(nxt);
            if constexpr (SP2) {
            PG8_LDB(B0, 0, 0); PG8_LDB(B1, 0, 1); PG8_SCHED; PG8_LDA(At, 0, 0); PG8_STAGE(PG8_SA(1, 1), a1 + hstep, voffA);
            PG8_WAIT_V(8); PG8_WAIT_L(0); PG8_BAR; PG8_MMA(0, 0, At, B0); PG8_MMA(0, 1, At, B1); PG8_BAR; PG8_SCHED;
            PG8_LDA(At, 0, 1); PG8_STAGE(PG8_SB(0, 0), b2, voffB); PG8_STAGE(PG8_SB(0, 1), b2 + hstep, voffB); PG8_STAGE(PG8_SA(0, 0), a2, voffA);
            PG8_WAIT_V(8); PG8_WAIT_L(0); PG8_BAR; PG8_MMA(1, 0, At, B0); PG8_MMA(1, 1, At, B1); PG8_BAR; PG8_SCHED;
            PG8_LDB(B0, 1, 0); PG8_LDB(B1, 1, 1); PG8_SCHED; PG8_LDA(At, 1, 0); PG8_STAGE(PG8_SA(0, 1), a2 + hstep, voffA);
            PG8_WAIT_V(8); PG8_WAIT_L(0); PG8_BAR; PG8_MMA(0, 0, At, B0); PG8_MMA(0, 1, At, B1); PG8_BAR; PG8_SCHED;
            PG8_LDA(At, 1, 1); PG8_STAGE(PG8_SB(1, 0), b3, voffB); PG8_STAGE(PG8_SB(1, 1), b3 + hstep, voffB); PG8_STAGE(PG8_SA(1, 0), a3, voffA);
            PG8_WAIT_V(8); PG8_WAIT_L(0); PG8_BAR; PG8_MMA(1, 0, At, B0); PG8_MMA(1, 1, At, B1); PG8_BAR; PG8_SCHED;
            } else {
            PG8_LDB(B0, 0, 0); PG8_SCHED; PG8_LDA(At, 0, 0); PG8_STAGE(PG8_SA(1, 1), a1 + hstep, voffA);
            PG8_WAIT_L(8); PG8_BAR; PG8_WAIT_L(0); PG8_MMA(0, 0, At, B0); PG8_BAR; PG8_SCHED;
            PG8_LDB(B1, 0, 1); PG8_STAGE(PG8_SB(0, 0), b2, voffB);
            PG8_BAR; PG8_WAIT_L(0); PG8_MMA(0, 1, At, B1); PG8_BAR;
            PG8_LDA(At, 0, 1); PG8_STAGE(PG8_SA(0, 0), a2, voffA);
            PG8_BAR; PG8_WAIT_L(0); PG8_MMA(1, 0, At, B0); PG8_BAR; PG8_SCHED;
            PG8_STAGE(PG8_SB(0, 1), b2 + hstep, voffB);
            PG8_WAIT_V(6); PG8_BAR; PG8_MMA(1, 1, At, B1); PG8_BAR;
            PG8_LDB(B0, 1, 0); PG8_SCHED; PG8_LDA(At, 1, 0); PG8_STAGE(PG8_SA(0, 1), a2 + hstep, voffA);
            PG8_WAIT_L(8); PG8_BAR; PG8_WAIT_L(0); PG8_MMA(0, 0, At, B0); PG8_BAR; PG8_SCHED;
            PG8_LDB(B1, 1, 1); PG8_STAGE(PG8_SB(1, 0), b3, voffB);
            PG8_BAR; PG8_WAIT_L(0); PG8_MMA(0, 1, At, B1); PG8_BAR;
            PG8_LDA(At, 1, 1); PG8_STAGE(PG8_SA(1, 0), a3, voffA);
            PG8_BAR; PG8_WAIT_L(0); PG8_MMA(1, 0, At, B0); PG8_BAR; PG8_SCHED;
            PG8_STAGE(PG8_SB(1, 1), b3 + hstep, voffB);
            PG8_WAIT_V(6); PG8_BAR; PG8_MMA(1, 1, At, B1); PG8_BAR;
            }
        }
        if constexpr (ALIGN_EPI) { if (wr == 0) PG8_BAR; }
        if constexpr (!Epi::AFTER_DRAIN) { E(acc, cur, wr, wc, fr, fq); S.done(cur); }
        if (!has_next) break;
#pragma unroll
        for (int a = 0; a < 2; ++a)
#pragma unroll
            for (int b = 0; b < 2; ++b)
#pragma unroll
                for (int m = 0; m < 4; ++m)
#pragma unroll
                    for (int n = 0; n < 2; ++n) acc[a][b][m][n] = (f32x4){0.f, 0.f, 0.f, 0.f};
        cur = nxt; cA = nA; cB = nB; ++ui;
        if constexpr (ALIGN_EPI) { if (wr == 1) PG8_BAR; }
    }
    PG8_WAIT_V(0);
    if constexpr (!ALIGN_EPI) { if (wr == 0) PG8_BAR; }
    PG8_BAR;
    if constexpr (Epi::AFTER_DRAIN) { E.fused(acc, cur, wr, wc, fr, fq, lds, wid, lane); S.done(cur); }
#undef PG8_SA
#undef PG8_SB
#undef PG8_STAGE
#undef PG8_LDA
#undef PG8_LDB
#undef PG8_MMA
#undef PG8_WAIT_V
#undef PG8_WAIT_L
#undef PG8_BAR
#undef PG8_SCHED
}
}
#define GAS __attribute__((address_space(1)))
#define LAS __attribute__((address_space(3)))
typedef unsigned short bf16;
typedef unsigned v4u __attribute__((ext_vector_type(4)));
typedef float f32x4 __attribute__((ext_vector_type(4)));
typedef short bf16x8 __attribute__((ext_vector_type(8)));
typedef GAS unsigned gu32;
typedef GAS unsigned long long gu64;
#define RLX_AGENT __ATOMIC_RELAXED, __HIP_MEMORY_SCOPE_AGENT
#define LDS_WAIT() asm volatile("s_waitcnt lgkmcnt(0)" ::: "memory")
#define VM_WAIT() asm volatile("s_waitcnt vmcnt(0)" ::: "memory")
__device__ __forceinline__ unsigned long long rt() { return __builtin_amdgcn_s_memrealtime(); }
__device__ __forceinline__ unsigned f2bf(float f) { unsigned u = __builtin_bit_cast(unsigned, f); return (u + 0x7fffu + ((u >> 16) & 1u)) >> 16; }
__device__ __forceinline__ unsigned pk2(float lo, float hi) { return f2bf(lo) | (f2bf(hi) << 16); }

#define XB_TMO      128
#define XB_XCNT(j)  (256  + 64 * (j))
#define XB_XSUB(j)  (1280 + 64 * (j))
#define XB_XGEN(j)  (2304 + 64 * (j))
#define XB_TOP      3328
#define XB_TOPGEN   3392
#define XCD_BAR_WORDS 3456
#define XB_SPIN_CAP (1u << 18)

__device__ __forceinline__ unsigned xb_ld(unsigned* p)              { return __hip_atomic_load(p, __ATOMIC_RELAXED, __HIP_MEMORY_SCOPE_AGENT); }
__device__ __forceinline__ unsigned xb_add(unsigned* p, unsigned v) { return __hip_atomic_fetch_add(p, v, __ATOMIC_RELAXED, __HIP_MEMORY_SCOPE_AGENT); }
__device__ __forceinline__ unsigned xb_xcc_id() { return (unsigned)__builtin_amdgcn_s_getreg((3 << 11) | 20) & 0xFu; }
#define XB_SPIN(cond, bar) do { unsigned _sp = 0; while (cond) { __builtin_amdgcn_s_sleep(1); \
    if ((++_sp & 255u) == 0u) { if (xb_ld(&(bar)[XB_TMO])) break; if (_sp > XB_SPIN_CAP) { atomicAdd(&(bar)[XB_TMO], 1u); break; } } } } while (0)

struct XcdBarrier {
    unsigned* bar; unsigned x;
    volatile LAS unsigned* st;
};

__device__ __forceinline__ XcdBarrier xcd_barrier_post(unsigned* bar, volatile LAS unsigned* st) {
    XcdBarrier b; b.bar = bar; b.x = xb_xcc_id(); b.st = st;
    if (threadIdx.x == 0) (void)xb_add(&bar[XB_XCNT(b.x)], 1u);
    return b;
}
__device__ __forceinline__ void xcd_barrier_complete(unsigned* bar, unsigned x, unsigned& nloc, unsigned& nx) {
    const unsigned G = gridDim.x * gridDim.y * gridDim.z;
    unsigned sum, cnt, mine, sp = 0u;
    for (;;) {
        sum = 0u; cnt = 0u; mine = 0u;
#pragma unroll
        for (unsigned j = 0; j < 16; ++j) { const unsigned c = xb_ld(&bar[XB_XCNT(j)]); sum += c; cnt += (c > 0u) ? 1u : 0u; mine = (j == x) ? c : mine; }
        if (sum == G) break;
        __builtin_amdgcn_s_sleep(1);
        if ((++sp & 255u) == 0u) { if (xb_ld(&bar[XB_TMO])) break; if (sp > XB_SPIN_CAP) { atomicAdd(&bar[XB_TMO], 1u); break; } }
    }
    nloc = mine > 0u ? mine : 1u; nx = cnt > 0u ? cnt : 1u;
}

__device__ __forceinline__ void xcd_barrier(const XcdBarrier& b) {
    asm volatile("s_waitcnt vmcnt(0)" ::: "memory");
    __syncthreads();
    if (threadIdx.x == 0) {
        unsigned* bar = b.bar;
        __builtin_amdgcn_s_waitcnt(0);
        unsigned nloc = b.st[0], nx = b.st[1];
        if (nloc == 0u) { xcd_barrier_complete(bar, b.x, nloc, nx); b.st[0] = nloc; b.st[1] = nx; }
        const unsigned old = xb_add(&bar[XB_XSUB(b.x)], 1u);
        const unsigned gen = old / nloc;
        if (old + 1u == (gen + 1u) * nloc) {
            __builtin_amdgcn_fence(__ATOMIC_RELEASE, "agent");
            asm volatile("s_waitcnt vmcnt(0)" ::: "memory");
            const unsigned og = xb_add(&bar[XB_TOP], 1u);
            const unsigned tg = og / nx;
            if (og + 1u == (tg + 1u) * nx) xb_add(&bar[XB_TOPGEN], 1u);
            else XB_SPIN(xb_ld(&bar[XB_TOPGEN]) == tg, bar);
            __builtin_amdgcn_fence(__ATOMIC_ACQUIRE, "agent");
            xb_add(&bar[XB_XGEN(b.x)], 1u);
            asm volatile("s_waitcnt vmcnt(0)" ::: "memory");
        } else {
            XB_SPIN(xb_ld(&bar[XB_XGEN(b.x)]) == gen, bar);
            __builtin_amdgcn_fence(__ATOMIC_ACQUIRE, "agent");
            asm volatile("s_waitcnt vmcnt(0)" ::: "memory");
        }
    }
    __syncthreads();
}
constexpr int NWAVES = 8;
constexpr int BATCH = 4, SEQ = 4096, DM = 4096, M = BATCH * SEQ;
constexpr int NH = 16, HD = 128, FOXW = 2048, NQKV = 6144, S5W = 1024, NGATE = 8192, N1 = NQKV + S5W + NGATE;
constexpr int INCOLS = 15376, DFF = 11008, NGU = 2 * DFF;
constexpr int S5G = 64, S5P = 64, S5C = 16;
constexpr float RMS_EPS = 1e-6f;
constexpr float LOG2E = 1.4426950408889634f;
constexpr float QSCALE = 0.08838834764831845f * LOG2E;
enum { I_X = 0, I_GMIX, I_WIN, I_BF, I_BG, I_QN, I_KN, I_LRE, I_LIM, I_LSTEP, I_BRE, I_BIM, I_CRE, I_CIM, I_SD, I_WGLU, I_BGLU, I_WPF, I_WPS, I_WOUT, I_GFFN, I_WGU, I_WDN, N_IN };

constexpr size_t MiB = 1u << 20;
constexpr size_t WS_CTL = 0, CTL_ZERO_BYTES = 1 * MiB;
constexpr size_t WS_RS1 = 1 * MiB, WS_RS2 = WS_RS1 + 65536;
constexpr size_t WS_LS = 2 * MiB, WS_FK = 3 * MiB;
constexpr size_t WS_HP = 4 * MiB;
constexpr size_t WS_WF = 8 * MiB;
constexpr size_t WS_S5T = 9 * MiB;
constexpr size_t WS_W1 = 16 * MiB, WS_WGLU = 136 * MiB, WS_WPF = 138 * MiB, WS_WPS = 154 * MiB, WS_WO = 162 * MiB, WS_WGU = 194 * MiB, WS_WD = 366 * MiB;
constexpr size_t WS_RA = 452 * MiB;
constexpr size_t WS_RB = 580 * MiB;
constexpr size_t WS_QKV = 708 * MiB, WS_S5IN = 900 * MiB, WS_GATES = 932 * MiB, WS_ACT = 708 * MiB;
constexpr size_t WS_ATTN = 1188 * MiB, WS_G = 1252 * MiB, WS_SSM = 1284 * MiB, WS_END = 1316 * MiB;
static_assert(WS_W1 + (size_t)N1 * DM * 2 <= WS_WGLU && WS_WGU + (size_t)NGU * DM * 2 <= WS_WD && WS_WD + (size_t)DM * DFF * 2 <= WS_RA, "weights map");
static_assert(WS_ACT + (size_t)M * DFF * 2 <= WS_ATTN && WS_GATES + (size_t)M * NGATE * 2 <= WS_ATTN, "activation map");
constexpr int CW_TMO = 0, CW_BAR = 4096;

constexpr int RING_OFF = 0, RING_BYTES = 131072;
constexpr int LDSCTL_OFF = RING_BYTES, MISC_OFF = LDSCTL_OFF + 320;
constexpr int LDS_BYTES = 147456;

__device__ __forceinline__ float wave_sum(float v) {
#pragma unroll
    for (int o = 1; o < 64; o <<= 1) v += __shfl_xor(v, o);
    return v;
}
__device__ __forceinline__ float wave_max(float v) {
#pragma unroll
    for (int o = 1; o < 64; o <<= 1) v = fmaxf(v, __shfl_xor(v, o));
    return v;
}
__device__ __forceinline__ float gelu_tanh(float x) {
    const float t = 0.7978845608028654f * (x + 0.044715f * x * x * x);
    const float e = __expf(-2.0f * fabsf(t)); float th = (1.0f - e) / (1.0f + e); th = t < 0.f ? -th : th;
    return 0.5f * x * (1.0f + th);
}
__device__ __forceinline__ float log_sigmoid_f(float v) { return fminf(v, 0.f) - log1pf(__expf(-fabsf(v))); }

__device__ __forceinline__ void p0_tr_item(const float* W, size_t ldw, int src_col, const float* kscale, bf16* WT, int K, int dst_row, int k0, LAS float* scr, int lane) {
#pragma unroll 8
    for (int i = 0; i < 32; ++i) { const int kk = 2 * i + (lane >> 5); float v = W[(size_t)(k0 + kk) * ldw + src_col + (lane & 31)]; if (kscale) v *= kscale[k0 + kk]; scr[kk * 33 + (lane & 31)] = v; }
    LDS_WAIT(); asm volatile("" ::: "memory");
    const int c = lane & 7;
#pragma unroll
    for (int j = 0; j < 4; ++j) { const int n = (lane >> 3) + 8 * j; const LAS float* s = scr + (8 * c) * 33 + n;
        v4u o; o.x = pk2(s[0 * 33], s[1 * 33]); o.y = pk2(s[2 * 33], s[3 * 33]); o.z = pk2(s[4 * 33], s[5 * 33]); o.w = pk2(s[6 * 33], s[7 * 33]);
        *(GAS v4u*)(WT + (size_t)(dst_row + n) * K + k0 + 8 * c) = o; }
    LDS_WAIT(); asm volatile("" ::: "memory");
}

struct Args { const float* in[N_IN]; float* out; unsigned char* ws; int ph_lo, ph_hi, li, pad; };

__global__ void __launch_bounds__(256) naive_attn(const bf16* __restrict__ QKV, const float* __restrict__ FK, bf16* __restrict__ O) {
    __shared__ float sc[4][SEQ];
    const int wave = threadIdx.x >> 6, lane = threadIdx.x & 63, gw = blockIdx.x * 4 + wave;
    const int row = gw >> 4, h = gw & 15, b = row / SEQ, t = row % SEQ;
    const bf16* q = QKV + (size_t)row * NQKV + h * HD;
    const bf16* Kb = QKV + (size_t)b * SEQ * NQKV + FOXW + h * HD;
    const bf16* Vb = QKV + (size_t)b * SEQ * NQKV + 2 * FOXW + h * HD;
    const float* fk = FK + (size_t)(b * NH + h) * SEQ;
    float mx = -INFINITY;
    for (int j0 = 0; j0 <= t; j0 += 64) { const int j = j0 + lane;
        if (j <= t) { const bf16* kr = Kb + (size_t)j * NQKV; float s = 0.f;
            for (int c = 0; c < 16; ++c) { const v4u kw = *(const v4u*)(kr + c * 8), qw = *(const v4u*)(q + c * 8);
                s += __uint_as_float(kw.x << 16) * __uint_as_float(qw.x << 16) + __uint_as_float(kw.x & 0xffff0000u) * __uint_as_float(qw.x & 0xffff0000u);
                s += __uint_as_float(kw.y << 16) * __uint_as_float(qw.y << 16) + __uint_as_float(kw.y & 0xffff0000u) * __uint_as_float(qw.y & 0xffff0000u);
                s += __uint_as_float(kw.z << 16) * __uint_as_float(qw.z << 16) + __uint_as_float(kw.z & 0xffff0000u) * __uint_as_float(qw.z & 0xffff0000u);
                s += __uint_as_float(kw.w << 16) * __uint_as_float(qw.w << 16) + __uint_as_float(kw.w & 0xffff0000u) * __uint_as_float(qw.w & 0xffff0000u); }
            s -= fk[j]; sc[wave][j] = s; mx = fmaxf(mx, s); } }
    mx = wave_max(mx);
    __syncthreads();
    float sum = 0.f;
    for (int j = lane; j <= t; j += 64) { const float p = exp2f(sc[wave][j] - mx); sc[wave][j] = p; sum += p; }
    sum = wave_sum(sum);
    __syncthreads();
    float a0 = 0.f, a1 = 0.f;
    for (int j = 0; j <= t; ++j) { const float p = sc[wave][j]; const unsigned vw = *(const unsigned*)(Vb + (size_t)j * NQKV + 2 * lane);
        a0 += p * __uint_as_float(vw << 16); a1 += p * __uint_as_float(vw & 0xffff0000u); }
    const float inv = 1.0f / sum;
    *(unsigned*)(O + (size_t)row * FOXW + h * HD + 2 * lane) = pk2(a0 * inv, a1 * inv);
}
__device__ __forceinline__ void sincos_small(float x, float& s, float& c) {
    const float k = rintf(x * 0.6366197723675814f);
    float r = fmaf(-k, 1.5707962512969971f, x); r = fmaf(-k, 7.549789415861596e-08f, r);
    const float r2 = r * r;
    const float sp = r + r * r2 * (-1.6666667e-1f + r2 * (8.3333333e-3f + r2 * (-1.9841270e-4f + r2 * 2.7557319e-6f)));
    const float cp = 1.0f + r2 * (-0.5f + r2 * (4.1666667e-2f + r2 * (-1.3888889e-3f + r2 * (2.4801587e-5f + r2 * -2.7557319e-7f))));
    const int q = ((int)k) & 3;
    s = (q == 0) ? sp : (q == 1) ? cp : (q == 2) ? -sp : -cp;
    c = (q == 0) ? cp : (q == 1) ? -sp : (q == 2) ? -cp : sp;
}
__global__ void __launch_bounds__(64) naive_s5(const bf16* __restrict__ S5IN, const float* lam_re, const float* lam_im, const float* log_step, const float* b_re, const float* b_im,
                                               const float* c_re, const float* c_im, const float* dd, bf16* __restrict__ G) {
    const int g = blockIdx.x & 63, b = blockIdx.x >> 6, p = threadIdx.x;
    const float lr = lam_re[g * 64 + p], li = lam_im[g * 64 + p], dt = __expf(log_step[g]);
    const float mag = __expf(lr * dt); float sn, cs; sincos_small(li * dt, sn, cs);
    const float lbr = mag * cs, lbi = mag * sn, den = lr * lr + li * li, nr = lbr - 1.0f;
    const float facr = (nr * lr + lbi * li) / den, faci = (lbi * lr - nr * li) / den;
    float Bbr[16], Bbi[16], Cr[16], Ci[16];
#pragma unroll
    for (int i = 0; i < 16; ++i) { const float br = b_re[(g * 64 + p) * 16 + i], bi = b_im[(g * 64 + p) * 16 + i];
        Bbr[i] = facr * br - faci * bi; Bbi[i] = facr * bi + faci * br; Cr[i] = c_re[(g * 16 + i) * 64 + p]; Ci[i] = c_im[(g * 16 + i) * 64 + p]; }
    const float dl = dd[g * 16 + (p & 15)];
    float xr = 0.f, xi = 0.f;
    for (int t = 0; t < SEQ; ++t) {
        const size_t ro = (size_t)(b * SEQ + t) * S5W + g * 16;
        const v4u w0 = *(const v4u*)(S5IN + ro), w1 = *(const v4u*)(S5IN + ro + 8);
        float u[16];
        u[0] = __uint_as_float(w0.x << 16); u[1] = __uint_as_float(w0.x & 0xffff0000u); u[2] = __uint_as_float(w0.y << 16); u[3] = __uint_as_float(w0.y & 0xffff0000u);
        u[4] = __uint_as_float(w0.z << 16); u[5] = __uint_as_float(w0.z & 0xffff0000u); u[6] = __uint_as_float(w0.w << 16); u[7] = __uint_as_float(w0.w & 0xffff0000u);
        u[8] = __uint_as_float(w1.x << 16); u[9] = __uint_as_float(w1.x & 0xffff0000u); u[10] = __uint_as_float(w1.y << 16); u[11] = __uint_as_float(w1.y & 0xffff0000u);
        u[12] = __uint_as_float(w1.z << 16); u[13] = __uint_as_float(w1.z & 0xffff0000u); u[14] = __uint_as_float(w1.w << 16); u[15] = __uint_as_float(w1.w & 0xffff0000u);
        float bur = 0.f, bui = 0.f;
#pragma unroll
        for (int i = 0; i < 16; ++i) { bur += Bbr[i] * u[i]; bui += Bbi[i] * u[i]; }
        const float nxr = lbr * xr - lbi * xi + bur, nxi = lbr * xi + lbi * xr + bui; xr = nxr; xi = nxi;
        float ysel = 0.f, usel = 0.f;
#pragma unroll
        for (int i = 0; i < 16; ++i) { const float tot = wave_sum(Cr[i] * xr - Ci[i] * xi); if ((p & 15) == i) { ysel = tot; usel = u[i]; } }
        const float y = ysel + dl * usel;
        if (p < 16) { const float gv = gelu_tanh(y); G[ro + p] = (bf16)f2bf(gv); }
    }
}

__global__ void __launch_bounds__(NWAVES * 64, 2) fwd(Args args) {
    extern __shared__ __attribute__((aligned(16))) unsigned char lds[];
    LAS unsigned char* L = (LAS unsigned char*)lds;
    volatile LAS unsigned* MISC = (volatile LAS unsigned*)(L + MISC_OFF);
    const int tid = threadIdx.x, lane = tid & 63, wave = __builtin_amdgcn_readfirstlane(tid >> 6);
    const int G = gridDim.x, bx = blockIdx.x;
    const int vcu = (G % 8 == 0) ? (bx % 8) * (G / 8) + bx / 8 : bx;
    const int gw = vcu * NWAVES + wave, NGW = G * NWAVES;
    unsigned char* ws = args.ws;
    gu32* ctl = (gu32*)(ws + WS_CTL);
    for (int u = tid; u < (LDS_BYTES - LDSCTL_OFF) / 4; u += NWAVES * 64) ((LAS unsigned*)(L + LDSCTL_OFF))[u] = 0u;
    __syncthreads();
    const int lo = args.ph_lo, hi = args.ph_hi;
    XcdBarrier bar; bar.bar = (unsigned*)(ctl + CW_BAR) + args.li * XCD_BAR_WORDS; bar.x = 0; bar.st = nullptr;
    if (hi - lo > 1) bar = xcd_barrier_post((unsigned*)(ctl + CW_BAR) + args.li * XCD_BAR_WORDS, MISC + 8);
#define IN(k) (lo <= (k) && (k) < hi)
#define BOTH(k) (IN(k) && IN((k) + 1))
#define GRID_BAR() xcd_barrier(bar)

    const float* x = args.in[I_X];
    float* out = args.out;
    float* RS1 = (float*)(ws + WS_RS1); float* RS2 = (float*)(ws + WS_RS2); float* LS = (float*)(ws + WS_LS); float* FK = (float*)(ws + WS_FK); float* HP = (float*)(ws + WS_HP);
    bf16* WF = (bf16*)(ws + WS_WF);
    bf16* W1 = (bf16*)(ws + WS_W1); bf16* WGLU = (bf16*)(ws + WS_WGLU); bf16* WPF = (bf16*)(ws + WS_WPF); bf16* WPS = (bf16*)(ws + WS_WPS);
    bf16* WO = (bf16*)(ws + WS_WO); bf16* WGU = (bf16*)(ws + WS_WGU); bf16* WD = (bf16*)(ws + WS_WD);
    bf16* XB = (bf16*)(ws + WS_RA); bf16* TMP = (bf16*)(ws + WS_RA); bf16* HB = (bf16*)(ws + WS_RA); bf16* MERGED = (bf16*)(ws + WS_RB);
    bf16* QKV = (bf16*)(ws + WS_QKV); bf16* S5IN = (bf16*)(ws + WS_S5IN); bf16* GATES = (bf16*)(ws + WS_GATES); bf16* ACT = (bf16*)(ws + WS_ACT);
    bf16* ATTN = (bf16*)(ws + WS_ATTN); bf16* GB = (bf16*)(ws + WS_G); bf16* SSM = (bf16*)(ws + WS_SSM);

    if (IN(0)) {
        LAS float* scr = (LAS float*)(L + RING_OFF + wave * 16384);
        constexpr int I1 = (DM / 64) * (N1 / 32), IGLU = (S5W / 64) * (S5W / 32), IPF = (FOXW / 64) * (DM / 32), IPS = (S5W / 64) * (DM / 32), IO = (DM / 64) * (DM / 32),
                      IGU = (DM / 64) * (NGU / 32), ID = (DFF / 64) * (DM / 32);
        constexpr int NITEMS = I1 + IGLU + IPF + IPS + IO + IGU + ID;
        for (int it = gw; it < NITEMS; it += NGW) {
            int r = it;
            if (r < I1) { const int nblk = N1 / 32, kb = r / nblk, nb = r % nblk, dr = 32 * nb; p0_tr_item(args.in[I_WIN], INCOLS, dr < NQKV ? dr : dr + 16, args.in[I_GMIX], W1, DM, dr, 64 * kb, scr, lane); continue; } r -= I1;
            if (r < IGLU) { const int nblk = S5W / 32, kb = r / nblk, nb = r % nblk; p0_tr_item(args.in[I_WGLU], S5W, 32 * nb, nullptr, WGLU, S5W, 32 * nb, 64 * kb, scr, lane); continue; } r -= IGLU;
            if (r < IPF) { const int nblk = DM / 32, kb = r / nblk, nb = r % nblk; p0_tr_item(args.in[I_WPF], DM, 32 * nb, nullptr, WPF, FOXW, 32 * nb, 64 * kb, scr, lane); continue; } r -= IPF;
            if (r < IPS) { const int nblk = DM / 32, kb = r / nblk, nb = r % nblk; p0_tr_item(args.in[I_WPS], DM, 32 * nb, nullptr, WPS, S5W, 32 * nb, 64 * kb, scr, lane); continue; } r -= IPS;
            if (r < IO) { const int nblk = DM / 32, kb = r / nblk, nb = r % nblk; p0_tr_item(args.in[I_WOUT], DM, 32 * nb, nullptr, WO, DM, 32 * nb, 64 * kb, scr, lane); continue; } r -= IO;
            if (r < IGU) { const int nblk = NGU / 32, kb = r / nblk, nb = r % nblk, dr = 32 * nb, t = dr >> 8, w = dr & 255;
                p0_tr_item(args.in[I_WGU], NGU, w < 128 ? 128 * t + w : DFF + 128 * t + (w - 128), args.in[I_GFFN], WGU, DM, dr, 64 * kb, scr, lane); continue; } r -= IGU;
            { const int nblk = DM / 32, kb = r / nblk, nb = r % nblk; p0_tr_item(args.in[I_WDN], DM, 32 * nb, nullptr, WD, DFF, 32 * nb, 64 * kb, scr, lane); }
        }
        for (int idx = bx * (NWAVES * 64) + tid; idx < 16 * DM; idx += G * NWAVES * 64) { const int k = idx >> 4, h = idx & 15;
            WF[(size_t)h * DM + k] = (bf16)f2bf(args.in[I_WIN][(size_t)k * INCOLS + NQKV + h] * args.in[I_GMIX][k]); }
        for (int m = gw; m < M; m += NGW) {
            const GAS f32x4* xr = (const GAS f32x4*)(x + (size_t)m * DM) + lane;
            f32x4 v[16]; float s = 0.f;
#pragma unroll
            for (int j = 0; j < 16; ++j) { v[j] = xr[64 * j]; s += (v[j].x * v[j].x + v[j].y * v[j].y) + (v[j].z * v[j].z + v[j].w * v[j].w); }
            const float tot = wave_sum(s);
            if (lane == 0) RS1[m] = 1.0f / sqrtf(tot * (1.0f / DM) + RMS_EPS);
            GAS unsigned long long* o8 = (GAS unsigned long long*)(XB + (size_t)m * DM) + lane;
#pragma unroll
            for (int j = 0; j < 16; ++j) o8[64 * j] = (unsigned long long)pk2(v[j].x, v[j].y) | ((unsigned long long)pk2(v[j].z, v[j].w) << 32);
        }
        if (BOTH(0)) GRID_BAR();
    }

    if (IN(1)) {
        if (vcu < M / 128) {
            const int r0 = vcu * 128 + wave * 16;
            const bf16* ap = XB + (size_t)(r0 + (lane & 15)) * DM + 8 * (lane >> 4);
            const bf16* bp = WF + (size_t)(lane & 15) * DM + 8 * (lane >> 4);
            f32x4 acc = {0.f, 0.f, 0.f, 0.f};
#pragma unroll 8
            for (int k0 = 0; k0 < DM; k0 += 32) { const bf16x8 a = *(const bf16x8*)(ap + k0); const bf16x8 b = *(const bf16x8*)(bp + k0);
                acc = __builtin_amdgcn_mfma_f32_16x16x32_bf16(a, b, acc, 0, 0, 0); }
            const int h = lane & 15; const float bfg = args.in[I_BF][h];
#pragma unroll
            for (int rg = 0; rg < 4; ++rg) { const int row = r0 + 4 * (lane >> 4) + rg; LS[(size_t)row * 16 + h] = log_sigmoid_f(acc[rg] * RS1[row] + bfg); }
        }
        pg8::Gemm g{XB, W1, M, N1, DM}; pg8::StaticOrder S; S.init(M, N1, G, bx);
        pg8::EpiZ E{QKV, S5IN, GATES, RS1, args.in[I_BG]};
        pg8::gemm_phase<pg8::EpiZ, pg8::StaticOrder, true, true>(L + RING_OFF, g, S, E);
        if (BOTH(1)) GRID_BAR();
    }

    if (IN(2)) {
        if (gw < BATCH * NH) {
            const int b = gw >> 4, h = gw & 15; const float* base = LS + (size_t)b * SEQ * 16 + h;
            float s = 0.f;
            for (int i = 0; i < 64; ++i) s += base[(size_t)(64 * lane + i) * 16];
            float incl = s;
#pragma unroll
            for (int o = 1; o < 64; o <<= 1) { const float t = __shfl_up(incl, o); if (lane >= o) incl += t; }
            float run = incl - s;
            float* fo = FK + (size_t)(b * NH + h) * SEQ + 64 * lane;
            for (int i = 0; i < 64; ++i) { run += base[(size_t)(64 * lane + i) * 16]; fo[i] = run * LOG2E; }
        }
        {
            const int c8 = (lane & 15) * 8; float wq[8], wk[8];
#pragma unroll
            for (int i = 0; i < 8; ++i) { wq[i] = args.in[I_QN][c8 + i] * QSCALE; wk[i] = args.in[I_KN][c8 + i]; }
            for (int m = gw; m < M; m += NGW) {
                bf16* rowp = QKV + (size_t)m * NQKV + (lane >> 4) * HD + c8;
                v4u w[8];
#pragma unroll
                for (int ps = 0; ps < 8; ++ps) w[ps] = *(const GAS v4u*)(rowp + ps * 4 * HD);
#pragma unroll
                for (int ps = 0; ps < 8; ++ps) {
                    float f[8]; f[0] = pg8::bf_lo(w[ps].x); f[1] = pg8::bf_hi(w[ps].x); f[2] = pg8::bf_lo(w[ps].y); f[3] = pg8::bf_hi(w[ps].y);
                    f[4] = pg8::bf_lo(w[ps].z); f[5] = pg8::bf_hi(w[ps].z); f[6] = pg8::bf_lo(w[ps].w); f[7] = pg8::bf_hi(w[ps].w);
                    float ss = 0.f;
#pragma unroll
                    for (int i = 0; i < 8; ++i) ss += f[i] * f[i];
                    ss += __shfl_xor(ss, 1); ss += __shfl_xor(ss, 2); ss += __shfl_xor(ss, 4); ss += __shfl_xor(ss, 8);
                    const float r = 1.0f / sqrtf(ss * (1.0f / HD) + RMS_EPS);
                    v4u o;
                    if (ps < 4) { o.x = pk2(f[0] * r * wq[0], f[1] * r * wq[1]); o.y = pk2(f[2] * r * wq[2], f[3] * r * wq[3]); o.z = pk2(f[4] * r * wq[4], f[5] * r * wq[5]); o.w = pk2(f[6] * r * wq[6], f[7] * r * wq[7]); }
                    else { o.x = pk2(f[0] * r * wk[0], f[1] * r * wk[1]); o.y = pk2(f[2] * r * wk[2], f[3] * r * wk[3]); o.z = pk2(f[4] * r * wk[4], f[5] * r * wk[5]); o.w = pk2(f[6] * r * wk[6], f[7] * r * wk[7]); }
                    *(GAS v4u*)(rowp + ps * 4 * HD) = o;
                }
            }
        }
        if (BOTH(2)) GRID_BAR();
    }

    if (IN(3)) {
        pg8::Gemm g{GB, WGLU, M, S5W, S5W}; pg8::StaticOrder S; S.init(M, S5W, G, bx);
        pg8::EpiGlu E{GB, SSM, args.in[I_BGLU], S5W};
        pg8::gemm_phase<pg8::EpiGlu, pg8::StaticOrder, true, true>(L + RING_OFF, g, S, E);
        if (BOTH(3)) GRID_BAR();
    }

    if (IN(4)) {
        { pg8::Gemm g{ATTN, WPF, M, DM, FOXW}; pg8::StaticOrder S; S.init(M, DM, G, bx);
          pg8::EpiGateMul E{GATES, NGATE, nullptr, TMP, DM};
          pg8::gemm_phase<pg8::EpiGateMul, pg8::StaticOrder, true, true>(L + RING_OFF, g, S, E); }
        VM_WAIT(); __syncthreads();
        { pg8::Gemm g{SSM, WPS, M, DM, S5W}; pg8::StaticOrder S; S.init(M, DM, G, bx);
          pg8::EpiGateMul E{GATES + DM, NGATE, TMP, MERGED, DM};
          pg8::gemm_phase<pg8::EpiGateMul, pg8::StaticOrder, true, true>(L + RING_OFF, g, S, E); }
        if (BOTH(4)) GRID_BAR();
    }

    if (IN(5)) {
        pg8::Gemm g{MERGED, WO, M, DM, DM}; pg8::StaticOrder S; S.init(M, DM, G, bx);
        pg8::EpiResid E{x, out, HB, HP, DM};
        pg8::gemm_phase<pg8::EpiResid, pg8::StaticOrder, true, true>(L + RING_OFF, g, S, E);
        if (BOTH(5)) GRID_BAR();
    }

    if (IN(6)) {
        for (int m = bx * (NWAVES * 64) + tid; m < M; m += G * NWAVES * 64) { const f32x4* hp = (const f32x4*)(HP + (size_t)m * 64); float s = 0.f;
#pragma unroll
            for (int j = 0; j < 16; ++j) { const f32x4 v = hp[j]; s += (v.x + v.y) + (v.z + v.w); }
            RS2[m] = 1.0f / sqrtf(s * (1.0f / DM) + RMS_EPS); }
        if (BOTH(6)) GRID_BAR();
    }

    if (IN(7)) {
        pg8::Gemm g{HB, WGU, M, NGU, DM}; pg8::StaticOrder S; S.init(M, NGU, G, bx);
        pg8::EpiSwiGlu E{ACT, RS2, DFF};
        pg8::gemm_phase<pg8::EpiSwiGlu, pg8::StaticOrder, true, true>(L + RING_OFF, g, S, E);
        if (BOTH(7)) GRID_BAR();
    }

    if (IN(8)) {
        pg8::Gemm g{ACT, WD, M, DM, DFF}; pg8::StaticOrder S; S.init(M, DM, G, bx);
        pg8::EpiResid E{out, out, nullptr, nullptr, DM};
        pg8::gemm_phase<pg8::EpiResid, pg8::StaticOrder, true, true>(L + RING_OFF, g, S, E);
    }
#undef IN
#undef BOTH
}

extern "C" void kernel_launch(void* const* d_in, const int* in_sizes, int n_in, void* d_out, int out_size, void* d_ws, size_t ws_size, hipStream_t stream) {
    static int grid = 0;
    if (grid == 0) {
        if (n_in != N_IN || in_sizes[0] != M * DM || out_size != M * DM || ws_size < WS_END) { fprintf(stderr, "kernel_launch: shape/workspace mismatch (n_in %d, in0 %d, out %d, ws %zu, need %zu)\n", n_in, n_in > 0 ? in_sizes[0] : -1, out_size, ws_size, (size_t)WS_END); grid = -1; return; }
        int dev = 0, cus = 0, per_cu = 0;
        if (hipGetDevice(&dev) != hipSuccess || hipDeviceGetAttribute(&cus, hipDeviceAttributeMultiprocessorCount, dev) != hipSuccess) { grid = -1; return; }
        if (hipFuncSetAttribute((const void*)fwd, hipFuncAttributeMaxDynamicSharedMemorySize, LDS_BYTES) != hipSuccess) { fprintf(stderr, "kernel_launch: hipFuncSetAttribute failed\n"); grid = -1; return; }
        if (hipOccupancyMaxActiveBlocksPerMultiprocessor(&per_cu, (const void*)fwd, NWAVES * 64, LDS_BYTES) != hipSuccess || per_cu < 1) fprintf(stderr, "kernel_launch: occupancy query says %d\n", per_cu);
        (void)hipGetLastError();
        grid = cus;
    }
    if (grid < 0) return;
    if (hipMemsetAsync((char*)d_ws + WS_CTL, 0, CTL_ZERO_BYTES, stream) != hipSuccess) return;
    Args a{};
    for (int i = 0; i < N_IN; ++i) a.in[i] = (const float*)d_in[i];
    a.out = (float*)d_out; a.ws = (unsigned char*)d_ws;
    unsigned char* ws = (unsigned char*)d_ws;
    int li = 0;
#define LAUNCH(lo_, hi_) do { a.ph_lo = (lo_); a.ph_hi = (hi_); a.li = li++; hipLaunchKernelGGL(fwd, dim3(grid), dim3(NWAVES * 64), LDS_BYTES, stream, a); } while (0)
    LAUNCH(0, 1); LAUNCH(1, 2); LAUNCH(2, 3);
    hipLaunchKernelGGL(naive_attn, dim3(M * NH / 4), dim3(256), 0, stream, (const bf16*)(ws + WS_QKV), (const float*)(ws + WS_FK), (bf16*)(ws + WS_ATTN));
    hipLaunchKernelGGL(naive_s5, dim3(BATCH * S5G), dim3(64), 0, stream, (const bf16*)(ws + WS_S5IN), (const float*)d_in[I_LRE], (const float*)d_in[I_LIM], (const float*)d_in[I_LSTEP],
                       (const float*)d_in[I_BRE], (const float*)d_in[I_BIM], (const float*)d_in[I_CRE], (const float*)d_in[I_CIM], (const float*)d_in[I_SD], (bf16*)(ws + WS_G));
    LAUNCH(3, 4); LAUNCH(4, 5); LAUNCH(5, 6); LAUNCH(6, 7); LAUNCH(7, 8); LAUNCH(8, 9);
#undef LAUNCH
    const hipError_t le = hipPeekAtLastError();
    if (le != hipSuccess) fprintf(stderr, "kernel_launch: launch failed: %s\n", hipGetErrorName(le));
}
```

```cpp
#include <hip/hip_runtime.h>
#include <hip/hip_bf16.h>
#include <cstdio>
#include <cstdint>
#include <cmath>
namespace pg8 {
#define PG8_LAS __attribute__((address_space(3)))
typedef unsigned short bf16_t;
typedef short bf16x8 __attribute__((ext_vector_type(8)));
typedef float f32x4 __attribute__((ext_vector_type(4)));
typedef unsigned u32x4 __attribute__((ext_vector_type(4)));
typedef int i32x4 __attribute__((ext_vector_type(4)));
__device__ __forceinline__ f32x4 pg8_mma(bf16x8 b, bf16x8 a, f32x4 c) { return __builtin_amdgcn_mfma_f32_16x16x32_bf16(b, a, c, 0, 0, 0); }
__device__ __forceinline__ i32x4 pg8_mma(bf16x8 b, bf16x8 a, i32x4 c) { return __builtin_amdgcn_mfma_i32_16x16x64_i8(__builtin_bit_cast(i32x4, b), __builtin_bit_cast(i32x4, a), c, 0, 0, 0); }
template <bool I8X> __device__ __forceinline__ f32x4 pg8_mma_x(bf16x8 b, bf16x8 a, f32x4 c) {
    if constexpr (I8X) return __builtin_bit_cast(f32x4, __builtin_amdgcn_mfma_i32_16x16x64_i8(__builtin_bit_cast(i32x4, b), __builtin_bit_cast(i32x4, a), __builtin_bit_cast(i32x4, c), 0, 0, 0));
    else return pg8_mma(b, a, c);
}
template <bool I8X> __device__ __forceinline__ i32x4 pg8_mma_x(bf16x8 b, bf16x8 a, i32x4 c) { return pg8_mma(b, a, c); }
__device__ __forceinline__ f32x4 pg8_zero(f32x4*) { return (f32x4){0.f, 0.f, 0.f, 0.f}; }
__device__ __forceinline__ i32x4 pg8_zero(i32x4*) { return (i32x4){0, 0, 0, 0}; }
constexpr int BM = 256, BK = 64, HALF = 128, HTB = HALF * BK * 2  , STAGE_BYTES = 8 * HTB, NXCD = 8, WGM = 8;

__host__ __device__ __forceinline__ int lds_byte(int r, int c) { const int st = (r >> 4) * 2 + (c >> 5), rr = r & 15, cc = c & 31, ob = rr * 64 + cc * 2; return st * 1024 + (ob ^ (((ob >> 9) & 1) << 5)); }
__host__ __device__ __forceinline__ void stage_rc(int b, int& R, int& C) { const int st = b / 1024, sb = b % 1024, swz = sb ^ (((sb >> 9) & 1) << 5); R = (st >> 1) * 16 + swz / 64; C = (st & 1) * 32 + (swz % 64) / 2; }
__host__ __device__ __forceinline__ int perm32(int rho) { const int n = rho >> 4, i = rho & 15; return 8 * (i >> 2) + 4 * n + (i & 3); }

struct Unit { int pm, pn; };
struct Gemm { const bf16_t* A; const bf16_t* Bt; int M, N, K; int KA; const bf16_t* A2; };

struct StaticOrder {
    int nM, nN, nwg, G, c, wgm;
    __host__ __device__ void init(int M, int N, int G_, int c_, int wgm_ = WGM) { nM = M / BM; nN = N / BM; nwg = nM * nN; G = G_; c = c_; wgm = wgm_; }
    __host__ __device__ bool next(int i, Unit& u) const {
        const long L = (long)i * G + c; if (L >= nwg) return false;
        int wgid = (int)L; { const int q = nwg / NXCD, r = nwg % NXCD, xcd = wgid % NXCD, off = wgid / NXCD; wgid = (xcd < r ? xcd * (q + 1) : r * (q + 1) + (xcd - r) * q) + off; }
        const int nig = wgm * nN, gid = wgid / nig, fm = gid * wgm, gsz = (nM - fm) < wgm ? (nM - fm) : wgm;
        u.pm = fm + ((wgid % nig) % gsz); u.pn = (wgid % nig) / gsz; return true;
    }
    __device__ __forceinline__ void a_ready(const Unit&) const {}
    __device__ __forceinline__ void done(const Unit&) const {}
};

typedef float f32x2c_t __attribute__((ext_vector_type(2))); typedef __bf16 bf16x2c_t __attribute__((ext_vector_type(2)));
__device__ __forceinline__ unsigned cvt_pk_bf16(float lo, float hi) { const f32x2c_t v = {lo, hi}; const bf16x2c_t b = __builtin_convertvector(v, bf16x2c_t); return __builtin_bit_cast(unsigned, b); }
typedef float f32x2 __attribute__((ext_vector_type(2)));
#define PG8_EPI_DRAIN() __builtin_amdgcn_s_waitcnt(0x0F70)
typedef unsigned u32x2 __attribute__((ext_vector_type(2)));
__device__ __forceinline__ unsigned gate_pack4(float a, float b, float c, float d) {
    unsigned r = __builtin_amdgcn_cvt_pk_u8_f32(a * 256.0f - 0.5f, 0, 0u); r = __builtin_amdgcn_cvt_pk_u8_f32(b * 256.0f - 0.5f, 1, r);
    r = __builtin_amdgcn_cvt_pk_u8_f32(c * 256.0f - 0.5f, 2, r); return __builtin_amdgcn_cvt_pk_u8_f32(d * 256.0f - 0.5f, 3, r);
}
__device__ __forceinline__ float gate_b0(unsigned w) { return (float)(w & 0xffu) + 0.5f; }
__device__ __forceinline__ float gate_b1(unsigned w) { return (float)((w >> 8) & 0xffu) + 0.5f; }
__device__ __forceinline__ float gate_b2(unsigned w) { return (float)((w >> 16) & 0xffu) + 0.5f; }
__device__ __forceinline__ float gate_b3(unsigned w) { return (float)(w >> 24) + 0.5f; }
__device__ __forceinline__ float sigmoid_f(float x) { return __builtin_amdgcn_rcpf(1.0f + __builtin_amdgcn_exp2f(-1.4426950408889634f * x)); }
__device__ __forceinline__ float bf_lo(unsigned w) { return __uint_as_float(w << 16); }
__device__ __forceinline__ float bf_hi(unsigned w) { return __uint_as_float(w & 0xffff0000u); }
__device__ __forceinline__ u32x4 pack8(const f32x4 v0, const f32x4 v1) { u32x4 w; w.x = cvt_pk_bf16(v0[0], v0[1]); w.y = cvt_pk_bf16(v0[2], v0[3]); w.z = cvt_pk_bf16(v1[0], v1[1]); w.w = cvt_pk_bf16(v1[2], v1[3]); return w; }

template <bool I8> struct acc_sel { typedef f32x4 t; }; template <> struct acc_sel<true> { typedef i32x4 t; };
__device__ __forceinline__ f32x4 to_f32(f32x4 a) { return a; }
__device__ __forceinline__ f32x4 to_f32(i32x4 a) { return __builtin_convertvector(a, f32x4); }
struct EpiZ {
    static constexpr bool PERM = true, AFTER_DRAIN = false; static constexpr int T_I8 = 0, MID_T = -1; typedef i32x4 acc_t;
    bf16_t* QKV; bf16_t* S5IN  ; unsigned char* GATES  ; const float* rs  ; const float* sw; const float* bg; const float* qn; const float* kn; float qscale, eps; PG8_LAS float* P;
    __device__ __forceinline__ void operator()(const i32x4 (&acc)[2][2][4][2], const Unit& u, int wr, int wc, int fr, int fq) const {
        const int row0 = u.pm * BM + wr * 64 + fr, colt = u.pn * BM + wc * 32 + 8 * fq;
        float rsv[2][4]; f32x4 sv[2][2];
#pragma unroll
        for (int ai = 0; ai < 2; ++ai)
#pragma unroll
            for (int m = 0; m < 4; ++m) rsv[ai][m] = rs[row0 + ai * HALF + m * 16];
#pragma unroll
        for (int bj = 0; bj < 2; ++bj)
#pragma unroll
            for (int n = 0; n < 2; ++n) sv[bj][n] = *(const f32x4*)(sw + colt + bj * HALF + 4 * n);
        if (u.pn < 16) {
            f32x4 w0, w1;
            { const float* wp = (u.pn < 8 ? qn : kn) + wc * 32 + 8 * fq; const float sc = u.pn < 8 ? qscale : 1.0f; w0 = *(const f32x4*)wp * sc; w1 = *(const f32x4*)(wp + 4) * sc; }
            asm volatile("" ::: "memory");
#pragma unroll
            for (int ai = 0; ai < 2; ++ai)
#pragma unroll
                for (int m = 0; m < 4; ++m) { const float s = rsv[ai][m];
#pragma unroll
                    for (int bj = 0; bj < 2; ++bj) { const f32x4 a = to_f32(acc[ai][bj][m][0]) * sv[bj][0] * s, b = to_f32(acc[ai][bj][m][1]) * sv[bj][1] * s;
                        float ss = (a[0] * a[0] + a[1] * a[1]) + (a[2] * a[2] + a[3] * a[3]) + (b[0] * b[0] + b[1] * b[1]) + (b[2] * b[2] + b[3] * b[3]);
                        ss += __shfl_xor(ss, 16); ss += __shfl_xor(ss, 32);
                        if (fq == 0) P[(ai * HALF + wr * 64 + m * 16 + fr) * 8 + bj * 4 + wc] = ss; } }
            asm volatile("s_waitcnt lgkmcnt(0)" ::: "memory"); __builtin_amdgcn_s_barrier(); asm volatile("" ::: "memory");
#pragma unroll
            for (int ai = 0; ai < 2; ++ai)
#pragma unroll
                for (int m = 0; m < 4; ++m) { const int r = row0 + ai * HALF + m * 16; bf16_t* rowp = QKV + (size_t)r * 6144 + colt;
#pragma unroll
                    for (int bj = 0; bj < 2; ++bj) { const f32x4 pp = *(const PG8_LAS f32x4*)(P + (ai * HALF + wr * 64 + m * 16 + fr) * 8 + bj * 4);
                        const float tot = (pp[0] + pp[1]) + (pp[2] + pp[3]); const float rr = rsv[ai][m] * __builtin_amdgcn_rsqf(tot * (1.0f / 128.0f) + eps);
                        const f32x4 v0 = to_f32(acc[ai][bj][m][0]) * sv[bj][0] * rr * w0, v1 = to_f32(acc[ai][bj][m][1]) * sv[bj][1] * rr * w1;
                        *(u32x4*)(rowp + bj * HALF) = pack8(v0, v1); } }
        } else if (u.pn >= 28) {
            const int col0 = colt - 28 * BM;
            f32x4 bv[2][2];
#pragma unroll
            for (int bj = 0; bj < 2; ++bj)
#pragma unroll
                for (int n = 0; n < 2; ++n) bv[bj][n] = *(const f32x4*)(bg + col0 + bj * HALF + 4 * n);
            asm volatile("" ::: "memory");
#pragma unroll
            for (int ai = 0; ai < 2; ++ai)
#pragma unroll
                for (int m = 0; m < 4; ++m) { const float s = rsv[ai][m]; unsigned char* rowp = GATES + (size_t)(row0 + ai * HALF + m * 16) * 8192 + col0;
#pragma unroll
                    for (int bj = 0; bj < 2; ++bj) { f32x4 v0 = to_f32(acc[ai][bj][m][0]) * sv[bj][0] * s + bv[bj][0], v1 = to_f32(acc[ai][bj][m][1]) * sv[bj][1] * s + bv[bj][1];
#pragma unroll
                        for (int e = 0; e < 4; ++e) { v0[e] = sigmoid_f(v0[e]); v1[e] = sigmoid_f(v1[e]); }
                        u32x2 o; o.x = gate_pack4(v0[0], v0[1], v0[2], v0[3]); o.y = gate_pack4(v1[0], v1[1], v1[2], v1[3]);
                        *(u32x2*)(rowp + bj * HALF) = o; } }
        } else if (u.pn >= 24) {
            const int col0 = colt - 24 * BM;
            asm volatile("" ::: "memory");
#pragma unroll
            for (int ai = 0; ai < 2; ++ai)
#pragma unroll
                for (int m = 0; m < 4; ++m) { const float s = rsv[ai][m]; const int r = row0 + ai * HALF + m * 16;
#pragma unroll
                    for (int bj = 0; bj < 2; ++bj) { const int col = col0 + bj * HALF;
                        *(u32x4*)(S5IN + ((size_t)(col >> 4) * (64 * BM) + r) * 16 + (col & 15)) = pack8(to_f32(acc[ai][bj][m][0]) * sv[bj][0] * s, to_f32(acc[ai][bj][m][1]) * sv[bj][1] * s); } }
        } else {
            asm volatile("" ::: "memory");
#pragma unroll
            for (int ai = 0; ai < 2; ++ai)
#pragma unroll
                for (int m = 0; m < 4; ++m) { const float s = rsv[ai][m]; bf16_t* rowp = QKV + (size_t)(row0 + ai * HALF + m * 16) * 6144 + colt;
#pragma unroll
                    for (int bj = 0; bj < 2; ++bj) *(u32x4*)(rowp + bj * HALF) = pack8(to_f32(acc[ai][bj][m][0]) * sv[bj][0] * s, to_f32(acc[ai][bj][m][1]) * sv[bj][1] * s); }
        }
        PG8_EPI_DRAIN();
    }
};
struct EpiGlu {
    static constexpr bool PERM = true, AFTER_DRAIN = false; static constexpr int T_I8 = 0, MID_T = -1; typedef f32x4 acc_t;
    const bf16_t* G; bf16_t* O; const float* bias; int ldc, ldo;
    __device__ __forceinline__ void operator()(const f32x4 (&acc)[2][2][4][2], const Unit& u, int wr, int wc, int fr, int fq) const {
        const int row0 = u.pm * BM + wr * 64 + fr, col0 = u.pn * BM + wc * 32 + 8 * fq;
        f32x4 bv[2][2];
#pragma unroll
        for (int bj = 0; bj < 2; ++bj)
#pragma unroll
            for (int n = 0; n < 2; ++n) bv[bj][n] = *(const f32x4*)(bias + col0 + bj * HALF + 4 * n);
        u32x4 gpre[2][4][2];
#pragma unroll
        for (int ai = 0; ai < 2; ++ai)
#pragma unroll
            for (int m = 0; m < 4; ++m)
#pragma unroll
                for (int bj = 0; bj < 2; ++bj) gpre[ai][m][bj] = *(const u32x4*)(G + (size_t)(row0 + ai * HALF + m * 16) * ldc + col0 + bj * HALF);
        asm volatile("" ::: "memory");
#pragma unroll
        for (int ai = 0; ai < 2; ++ai)
#pragma unroll
            for (int m = 0; m < 4; ++m) { const size_t offo = (size_t)(row0 + ai * HALF + m * 16) * ldo + col0;
#pragma unroll
                for (int bj = 0; bj < 2; ++bj) { const u32x4 gw = gpre[ai][m][bj];
                    f32x4 v0 = acc[ai][bj][m][0] + bv[bj][0], v1 = acc[ai][bj][m][1] + bv[bj][1];
                    v0[0] = bf_lo(gw.x) * sigmoid_f(v0[0]); v0[1] = bf_hi(gw.x) * sigmoid_f(v0[1]); v0[2] = bf_lo(gw.y) * sigmoid_f(v0[2]); v0[3] = bf_hi(gw.y) * sigmoid_f(v0[3]);
                    v1[0] = bf_lo(gw.z) * sigmoid_f(v1[0]); v1[1] = bf_hi(gw.z) * sigmoid_f(v1[1]); v1[2] = bf_lo(gw.w) * sigmoid_f(v1[2]); v1[3] = bf_hi(gw.w) * sigmoid_f(v1[3]);
                    *(u32x4*)(O + offo + bj * HALF) = pack8(v0, v1); } }
    }
};
template <bool MAXP> struct EpiProjT {
    static constexpr bool PERM = true, AFTER_DRAIN = false; static constexpr int T_I8 = 0, MID_T = 2048 / BK; typedef f32x4 acc_t;
    const unsigned char* gate  ; int ldg, goff; bf16_t* O; int ldc; float* mp;
    __device__ __forceinline__ void mid(f32x4 (&acc)[2][2][4][2], const Unit& u, int wr, int wc, int fr, int fq) const {
        int row0 = u.pm * BM + wr * 64 + fr, col0 = u.pn * BM + wc * 32 + 8 * fq;
        asm volatile("" : "+v"(row0), "+v"(col0));
        u32x2 fw[2][4][2], sw[2][4][2];
#pragma unroll
        for (int ai = 0; ai < 2; ++ai)
#pragma unroll
            for (int m = 0; m < 4; ++m) { const size_t goffs = (size_t)(row0 + ai * HALF + m * 16) * ldg + col0;
#pragma unroll
                for (int bj = 0; bj < 2; ++bj) { fw[ai][m][bj] = *(const u32x2*)(gate + goffs + bj * HALF); sw[ai][m][bj] = *(const u32x2*)(gate + goffs + goff + bj * HALF); } }
        asm volatile("" ::: "memory");
#pragma unroll
        for (int ai = 0; ai < 2; ++ai)
#pragma unroll
            for (int m = 0; m < 4; ++m)
#pragma unroll
                for (int bj = 0; bj < 2; ++bj) { const u32x2 f = fw[ai][m][bj], g = sw[ai][m][bj];
                    f32x4& v0 = acc[ai][bj][m][0]; f32x4& v1 = acc[ai][bj][m][1];
                    v0[0] *= gate_b0(f.x) * __builtin_amdgcn_rcpf(gate_b0(g.x)); v0[1] *= gate_b1(f.x) * __builtin_amdgcn_rcpf(gate_b1(g.x));
                    v0[2] *= gate_b2(f.x) * __builtin_amdgcn_rcpf(gate_b2(g.x)); v0[3] *= gate_b3(f.x) * __builtin_amdgcn_rcpf(gate_b3(g.x));
                    v1[0] *= gate_b0(f.y) * __builtin_amdgcn_rcpf(gate_b0(g.y)); v1[1] *= gate_b1(f.y) * __builtin_amdgcn_rcpf(gate_b1(g.y));
                    v1[2] *= gate_b2(f.y) * __builtin_amdgcn_rcpf(gate_b2(g.y)); v1[3] *= gate_b3(f.y) * __builtin_amdgcn_rcpf(gate_b3(g.y)); }
    }
    __device__ __forceinline__ void operator()(const f32x4 (&acc)[2][2][4][2], const Unit& u, int wr, int wc, int fr, int fq) const {
        const int row0 = u.pm * BM + wr * 64 + fr, col0 = u.pn * BM + wc * 32 + 8 * fq;
        u32x2 gpre[2][4][2];
#pragma unroll
        for (int ai = 0; ai < 2; ++ai)
#pragma unroll
            for (int m = 0; m < 4; ++m)
#pragma unroll
                for (int bj = 0; bj < 2; ++bj) gpre[ai][m][bj] = *(const u32x2*)(gate + (size_t)(row0 + ai * HALF + m * 16) * ldg + col0 + goff + bj * HALF);
        asm volatile("" ::: "memory");
#pragma unroll
        for (int ai = 0; ai < 2; ++ai)
#pragma unroll
            for (int m = 0; m < 4; ++m) { const int r = row0 + ai * HALF + m * 16; const size_t off = (size_t)r * ldc + col0; float mx = 0.f;
#pragma unroll
                for (int bj = 0; bj < 2; ++bj) { const u32x2 gw = gpre[ai][m][bj]; constexpr float q = 1.0f / 256.0f;
                    f32x4 v0 = acc[ai][bj][m][0], v1 = acc[ai][bj][m][1];
                    v0[0] *= gate_b0(gw.x) * q; v0[1] *= gate_b1(gw.x) * q; v0[2] *= gate_b2(gw.x) * q; v0[3] *= gate_b3(gw.x) * q;
                    v1[0] *= gate_b0(gw.y) * q; v1[1] *= gate_b1(gw.y) * q; v1[2] *= gate_b2(gw.y) * q; v1[3] *= gate_b3(gw.y) * q;
                    if constexpr (MAXP) { const f32x4 a0 = __builtin_elementwise_abs(v0), a1 = __builtin_elementwise_abs(v1);
                    mx = fmaxf(mx, fmaxf(fmaxf(fmaxf(a0[0], a0[1]), fmaxf(a0[2], a0[3])), fmaxf(fmaxf(a1[0], a1[1]), fmaxf(a1[2], a1[3])))); }
                    *(u32x4*)(O + off + bj * HALF) = pack8(v0, v1); }
                if constexpr (MAXP) { mx = fmaxf(mx, __shfl_xor(mx, 16)); mx = fmaxf(mx, __shfl_xor(mx, 32)); if (fq == 0) mp[(size_t)r * 64 + u.pn * 4 + wc] = mx; } }
    }
};
typedef EpiProjT<true> EpiProj;
template <bool BASE16, bool OUT, bool HB, bool I8 = false> struct EpiResid {
    static constexpr bool PERM = false, AFTER_DRAIN = false; static constexpr int T_I8 = 0, MID_T = -1; typedef typename acc_sel<I8>::t acc_t;
    const float* base; const bf16_t* base16; float* out; bf16_t* hb; float* hp; int ldc; const float* sa; const float* sb;
    __device__ __forceinline__ void operator()(const acc_t (&acc)[2][2][4][2], const Unit& u, int wr, int wc, int fr, int fq) const {
        typedef unsigned u32x2v __attribute__((ext_vector_type(2)));
        const int row0 = u.pm * BM + wr * 64 + fr, col0 = u.pn * BM + wc * 32 + 4 * fq;
        f32x4 sbv[2][2];
        if constexpr (I8) {
#pragma unroll
            for (int bj = 0; bj < 2; ++bj)
#pragma unroll
                for (int n = 0; n < 2; ++n) sbv[bj][n] = *(const f32x4*)(sb + col0 + bj * HALF + n * 16); }
        u32x2v raw[2][4][2][2];
        if constexpr (BASE16) {
#pragma unroll
            for (int ai = 0; ai < 2; ++ai)
#pragma unroll
                for (int m = 0; m < 4; ++m) { const size_t off = (size_t)(row0 + ai * HALF + m * 16) * ldc + col0;
#pragma unroll
                    for (int bj = 0; bj < 2; ++bj)
#pragma unroll
                        for (int n = 0; n < 2; ++n) raw[ai][m][bj][n] = *(const u32x2v*)(base16 + off + bj * HALF + n * 16); }
            asm volatile("" ::: "memory"); }
#pragma unroll
        for (int ai = 0; ai < 2; ++ai) {
            f32x4 pre[4][2][2];
            float sav[4];
            if constexpr (I8) {
#pragma unroll
                for (int m = 0; m < 4; ++m) sav[m] = sa[row0 + ai * HALF + m * 16]; }
#pragma unroll
            for (int m = 0; m < 4; ++m) { const size_t off = (size_t)(row0 + ai * HALF + m * 16) * ldc + col0;
#pragma unroll
                for (int bj = 0; bj < 2; ++bj)
#pragma unroll
                    for (int n = 0; n < 2; ++n) {
                        if constexpr (BASE16) { const u32x2v bw = raw[ai][m][bj][n]; pre[m][bj][n] = (f32x4){bf_lo(bw.x), bf_hi(bw.x), bf_lo(bw.y), bf_hi(bw.y)}; }
                        else pre[m][bj][n] = *(const f32x4*)(base + off + bj * HALF + n * 16); } }
            asm volatile("" ::: "memory");
#pragma unroll
            for (int m = 0; m < 4; ++m) { const int r = row0 + ai * HALF + m * 16; const size_t off = (size_t)r * ldc + col0; float ss = 0.f;
#pragma unroll
                for (int bj = 0; bj < 2; ++bj)
#pragma unroll
                    for (int n = 0; n < 2; ++n) { f32x4 o;
                        if constexpr (I8) o = pre[m][bj][n] + to_f32(acc[ai][bj][m][n]) * sbv[bj][n] * sav[m]; else o = pre[m][bj][n] + to_f32(acc[ai][bj][m][n]);
                        if constexpr (OUT) *(f32x4*)(out + off + bj * HALF + n * 16) = o;
                        if constexpr (HB) { u32x2v w; w.x = cvt_pk_bf16(o[0], o[1]); w.y = cvt_pk_bf16(o[2], o[3]); *(u32x2v*)(hb + off + bj * HALF + n * 16) = w;
                                  ss += (o[0] * o[0] + o[1] * o[1]) + (o[2] * o[2] + o[3] * o[3]); } }
                if constexpr (HB) { ss += __shfl_xor(ss, 16); ss += __shfl_xor(ss, 32); if (fq == 0) hp[(size_t)r * 64 + u.pn * 4 + wc] = ss; } }
            asm volatile("" ::: "memory");
        }
    }
};
template <int TI8> struct EpiSwiGluT {
    static constexpr bool PERM = true, AFTER_DRAIN = false; static constexpr int T_I8 = TI8, MID_T = -1; typedef f32x4 acc_t;
    bf16_t* O; const float* rs; int ldc; const float* sa; const float* sb;
    __device__ __forceinline__ void mid(f32x4 (&acc)[2][2][4][2], const Unit& u, int wr, int wc, int fr, int fq) const {
        int row0 = u.pm * BM + wr * 64 + fr; asm volatile("" : "+v"(row0));
        float sv[2][4];
#pragma unroll
        for (int ai = 0; ai < 2; ++ai)
#pragma unroll
            for (int m = 0; m < 4; ++m) sv[ai][m] = sa[row0 + ai * HALF + m * 16];
#pragma unroll
        for (int ai = 0; ai < 2; ++ai)
#pragma unroll
            for (int m = 0; m < 4; ++m)
#pragma unroll
                for (int bj = 0; bj < 2; ++bj)
#pragma unroll
                    for (int n = 0; n < 2; ++n) acc[ai][bj][m][n] = __builtin_convertvector(__builtin_bit_cast(i32x4, acc[ai][bj][m][n]), f32x4) * sv[ai][m];
    }
    __device__ __forceinline__ void operator()(const f32x4 (&acc)[2][2][4][2], const Unit& u, int wr, int wc, int fr, int fq) const {
        const int row0 = u.pm * BM + wr * 64 + fr, col0 = u.pn * HALF + wc * 32 + 8 * fq;
        float rsv[2][4];
#pragma unroll
        for (int ai = 0; ai < 2; ++ai)
#pragma unroll
            for (int m = 0; m < 4; ++m) rsv[ai][m] = rs[row0 + ai * HALF + m * 16];
        f32x4 cg[2] = {{1.f, 1.f, 1.f, 1.f}, {1.f, 1.f, 1.f, 1.f}}, cu[2] = {{1.f, 1.f, 1.f, 1.f}, {1.f, 1.f, 1.f, 1.f}};
        if constexpr (TI8 > 0) { const float* sp = sb + u.pn * BM + wc * 32 + 8 * fq;
            cg[0] = *(const f32x4*)sp; cg[1] = *(const f32x4*)(sp + 4); cu[0] = *(const f32x4*)(sp + HALF); cu[1] = *(const f32x4*)(sp + HALF + 4); }
        asm volatile("" ::: "memory");
#pragma unroll
        for (int ai = 0; ai < 2; ++ai)
#pragma unroll
            for (int m = 0; m < 4; ++m) { const int r = row0 + ai * HALF + m * 16; const float s = rsv[ai][m];
                f32x4 g0 = acc[ai][0][m][0] * s, g1 = acc[ai][0][m][1] * s; f32x4 u0 = acc[ai][1][m][0] * s, u1 = acc[ai][1][m][1] * s;
                if constexpr (TI8 > 0) { g0 = g0 * cg[0]; g1 = g1 * cg[1]; u0 = u0 * cu[0]; u1 = u1 * cu[1]; }
#pragma unroll
                for (int e = 0; e < 4; ++e) { g0[e] = g0[e] * sigmoid_f(g0[e]) * u0[e]; g1[e] = g1[e] * sigmoid_f(g1[e]) * u1[e]; }
                *(u32x4*)(O + (size_t)r * ldc + col0) = pack8(g0, g1); }
    }
};
typedef EpiSwiGluT<0> EpiSwiGlu;

template <class Epi, class Sched, bool ALIGN_EPI = false, bool SP2 = false>
__device__ __forceinline__ void gemm_phase(PG8_LAS unsigned char* lds, const Gemm g, const Sched& S, const Epi& E) {
    const int tid = threadIdx.x, wid = __builtin_amdgcn_readfirstlane(tid >> 6), lane = tid & 63, wr = wid >> 2, wc = wid & 3, fr = lane & 15, fq = lane >> 4;
    constexpr int T1 = Epi::T_I8;
    const int K = g.K, nt = K / BK, KA = T1 > 0 ? g.KA : g.K;
    unsigned voffA[2], voffB[2];
#pragma unroll
    for (int i = 0; i < 2; ++i) { int R, C; stage_rc(tid * 16 + i * 8192, R, C); const int Rb = Epi::PERM ? ((R & ~31) + perm32(R & 31)) : R;
        voffA[i] = (unsigned)(R * KA + C) * 2u; voffB[i] = (unsigned)(Rb * K + C) * 2u; }
    const size_t kstep = (size_t)(BK * 2);
    const size_t hstep = (size_t)HALF * K * 2, hstepA = (size_t)HALF * KA * 2;
    const size_t tstep = 2 * hstep, tstepA = 2 * hstepA;
    const unsigned ldsw = (unsigned)wid * 1024u;
    const int aoff = lds_byte(wr * 64 + fr, fq * 8), boff = lds_byte(wc * 32 + fr, fq * 8);
#define PG8_SA(b, h) (((b) * 2 + (h)) * HTB)
#define PG8_SB(b, h) ((4 + (b) * 2 + (h)) * HTB)
#define PG8_STAGE(bufoff, gbase, voff) do { _Pragma("unroll") for (int _i = 0; _i < 2; ++_i) { const char* _gb = (const char*)(gbase); asm volatile("" : "+s"(_gb));     \
        __builtin_amdgcn_global_load_lds((const unsigned*)(_gb + (voff)[_i]), (PG8_LAS unsigned*)(lds + (bufoff) + ldsw + _i * 8192), 16, 0, 0); } } while (0)
#define PG8_LDA(dst, b, h) do { _Pragma("unroll") for (int m = 0; m < 4; ++m) _Pragma("unroll") for (int k = 0; k < 2; ++k) dst[m][k] = *(const PG8_LAS bf16x8*)(lds + PG8_SA(b, h) + aoff + m * 2048 + k * 1024); } while (0)
#define PG8_LDB(dst, b, h) do { _Pragma("unroll") for (int n = 0; n < 2; ++n) _Pragma("unroll") for (int k = 0; k < 2; ++k) dst[n][k] = *(const PG8_LAS bf16x8*)(lds + PG8_SB(b, h) + boff + n * 2048 + k * 1024); } while (0)
#define PG8_MMA(I8X, ai, bj, At, Bt) do { __builtin_amdgcn_s_setprio(1); _Pragma("unroll") for (int m = 0; m < 4; ++m) _Pragma("unroll") for (int n = 0; n < 2; ++n) _Pragma("unroll") for (int k = 0; k < 2; ++k) \
        acc[ai][bj][m][n] = pg8_mma_x<I8X>(Bt[n][k], At[m][k], acc[ai][bj][m][n]); __builtin_amdgcn_s_setprio(0); } while (0)
#define PG8_WAIT_V(n) asm volatile("s_waitcnt vmcnt(" #n ")" ::: "memory")
#define PG8_WAIT_L(n) asm volatile("s_waitcnt lgkmcnt(" #n ")" ::: "memory")
#define PG8_BAR __builtin_amdgcn_s_barrier()
#define PG8_SCHED __builtin_amdgcn_sched_barrier(0)
    Unit cur, nxt; int ui = 0;
    if (!S.next(0, cur)) return;
    typedef typename Epi::acc_t acc_t;
    acc_t acc[2][2][4][2];
#pragma unroll
    for (int a = 0; a < 2; ++a)
#pragma unroll
        for (int b = 0; b < 2; ++b)
#pragma unroll
            for (int m = 0; m < 4; ++m)
#pragma unroll
                for (int n = 0; n < 2; ++n) acc[a][b][m][n] = pg8_zero((acc_t*)nullptr);
    bf16x8 At[4][2], B0[2][2], B1[2][2];
    const char* cA = (const char*)g.A + (size_t)cur.pm * tstepA; const char* cB = (const char*)g.Bt + (size_t)cur.pn * tstep;
    S.a_ready(cur);
    static_assert(SP2, "only the two-super-phase K-loop is kept");
    PG8_STAGE(PG8_SB(0, 0), cB, voffB); PG8_STAGE(PG8_SB(0, 1), cB + hstep, voffB); PG8_STAGE(PG8_SA(0, 0), cA, voffA); PG8_STAGE(PG8_SA(0, 1), cA + hstepA, voffA);
    if (wr == 1) PG8_BAR;
    PG8_WAIT_V(2); PG8_BAR;
    PG8_STAGE(PG8_SB(1, 0), cB + kstep, voffB); PG8_STAGE(PG8_SA(1, 0), cA + kstep, voffA);
    PG8_WAIT_V(4); PG8_BAR;
    for (;;) {
        const bool has_next = S.next(ui + 1, nxt);
        const char* nA = has_next ? (const char*)g.A + (size_t)nxt.pm * tstepA : cA; const char* nB = has_next ? (const char*)g.Bt + (size_t)nxt.pn * tstep : cB;
#define PG8_KBODY(I8X) do { \
            PG8_LDB(B0, 0, 0); PG8_LDB(B1, 0, 1); PG8_SCHED; PG8_LDA(At, 0, 0); PG8_STAGE(PG8_SB(1, 1), b1 + hstep, voffB); PG8_STAGE(PG8_SA(1, 1), a1 + hstepA, voffA); \
            PG8_WAIT_V(8); PG8_WAIT_L(0); PG8_BAR; PG8_MMA(I8X, 0, 0, At, B0); PG8_MMA(I8X, 0, 1, At, B1); PG8_BAR; PG8_SCHED; \
            PG8_LDA(At, 0, 1); PG8_STAGE(PG8_SB(0, 0), b2, voffB); PG8_STAGE(PG8_SA(0, 0), a2, voffA); \
            PG8_WAIT_V(6); PG8_WAIT_L(0); PG8_BAR; PG8_MMA(I8X, 1, 0, At, B0); PG8_MMA(I8X, 1, 1, At, B1); PG8_BAR; PG8_SCHED; \
            PG8_LDB(B0, 1, 0); PG8_LDB(B1, 1, 1); PG8_SCHED; PG8_LDA(At, 1, 0); PG8_STAGE(PG8_SB(0, 1), b2 + hstep, voffB); PG8_STAGE(PG8_SA(0, 1), a2 + hstepA, voffA); \
            PG8_WAIT_V(8); PG8_WAIT_L(0); PG8_BAR; PG8_MMA(I8X, 0, 0, At, B0); PG8_MMA(I8X, 0, 1, At, B1); PG8_BAR; PG8_SCHED; \
            PG8_LDA(At, 1, 1); PG8_STAGE(PG8_SB(1, 0), b3, voffB); PG8_STAGE(PG8_SA(1, 0), a3, voffA); \
            PG8_WAIT_V(6); PG8_WAIT_L(0); PG8_BAR; PG8_MMA(I8X, 1, 0, At, B0); PG8_MMA(I8X, 1, 1, At, B1); PG8_BAR; PG8_SCHED; } while (0)
        if constexpr (T1 > 0) {
            const char* cA2 = cA + ((const char*)g.A2 - (const char*)g.A);
            for (int t = 0; t < T1; t += 2) {
                asm volatile("" : "+v"(voffA[0]), "+v"(voffA[1]), "+v"(voffB[0]), "+v"(voffB[1]));
                const char* a1 = cA + (size_t)(t + 1) * kstep; const char* b1 = cB + (size_t)(t + 1) * kstep;
                const char* a2 = (t == T1 - 2 ? cA2 : cA) + (size_t)(t + 2) * kstep; const char* b2 = cB + (size_t)(t + 2) * kstep;
                const char* a3 = a2 + kstep; const char* b3 = b2 + kstep;
                PG8_KBODY(true);
            }
            E.mid(acc, cur, wr, wc, fr, fq);
            for (int t = T1; t < nt; t += 2) {
                const bool last = (t == nt - 2);
                asm volatile("" : "+v"(voffA[0]), "+v"(voffA[1]), "+v"(voffB[0]), "+v"(voffB[1]));
                const char* a1 = cA2 + (size_t)(t + 1) * kstep; const char* b1 = cB + (size_t)(t + 1) * kstep;
                const char* a2 = last ? nA : cA2 + (size_t)(t + 2) * kstep; const char* b2 = last ? nB : cB + (size_t)(t + 2) * kstep;
                const char* a3 = a2 + kstep; const char* b3 = b2 + kstep;
                if (last && has_next) S.a_ready(nxt);
                PG8_KBODY(false);
            }
        } else {
        for (int t = 0; t < nt; t += 2) {
            if constexpr (Epi::MID_T >= 0) { if (t == Epi::MID_T) E.mid(acc, cur, wr, wc, fr, fq); }
            const bool last = (t == nt - 2);
            asm volatile("" : "+v"(voffA[0]), "+v"(voffA[1]), "+v"(voffB[0]), "+v"(voffB[1]));
            const char* a1 = cA + (size_t)(t + 1) * kstep; const char* b1 = cB + (size_t)(t + 1) * kstep;
            const char* a2 = last ? nA : cA + (size_t)(t + 2) * kstep; const char* b2 = last ? nB : cB + (size_t)(t + 2) * kstep;
            const char* a3 = a2 + kstep; const char* b3 = b2 + kstep;
            if (last && has_next) S.a_ready(nxt);
            PG8_KBODY(false);
        }
        }
        if constexpr (ALIGN_EPI) { if (wr == 0) PG8_BAR; }
        if constexpr (!Epi::AFTER_DRAIN) { E(acc, cur, wr, wc, fr, fq); S.done(cur); }
        if (!has_next) break;
#pragma unroll
        for (int a = 0; a < 2; ++a)
#pragma unroll
            for (int b = 0; b < 2; ++b)
#pragma unroll
                for (int m = 0; m < 4; ++m)
#pragma unroll
                    for (int n = 0; n < 2; ++n) acc[a][b][m][n] = pg8_zero((acc_t*)nullptr);
        cur = nxt; cA = nA; cB = nB; ++ui;
        if constexpr (ALIGN_EPI) { if (wr == 1) PG8_BAR; }
    }
    PG8_WAIT_V(0);
    if constexpr (!ALIGN_EPI) { if (wr == 0) PG8_BAR; }
    PG8_BAR;
    if constexpr (Epi::AFTER_DRAIN) { E.fused(acc, cur, wr, wc, fr, fq, lds, wid, lane); S.done(cur); }
#undef PG8_SA
#undef PG8_SB
#undef PG8_STAGE
#undef PG8_LDA
#undef PG8_LDB
#undef PG8_MMA
#undef PG8_KBODY
#undef PG8_WAIT_V
#undef PG8_WAIT_L
#undef PG8_BAR
#undef PG8_SCHED
}
}
#define GAS __attribute__((address_space(1)))
#define LAS __attribute__((address_space(3)))
typedef unsigned short bf16;
typedef unsigned v4u __attribute__((ext_vector_type(4)));
typedef float f32x4 __attribute__((ext_vector_type(4)));
typedef short bf16x8 __attribute__((ext_vector_type(8)));
typedef GAS unsigned gu32;
typedef GAS unsigned long long gu64;
#define RLX_AGENT __ATOMIC_RELAXED, __HIP_MEMORY_SCOPE_AGENT
#define LDS_WAIT() asm volatile("s_waitcnt lgkmcnt(0)" ::: "memory")
#define VM_WAIT() asm volatile("s_waitcnt vmcnt(0)" ::: "memory")
__device__ __forceinline__ unsigned long long rt() { return __builtin_amdgcn_s_memrealtime(); }
__device__ __forceinline__ unsigned f2bf(float f) { unsigned u = __builtin_bit_cast(unsigned, f); return (u + 0x7fffu + ((u >> 16) & 1u)) >> 16; }
__device__ __forceinline__ unsigned pk2(float lo, float hi) { return f2bf(lo) | (f2bf(hi) << 16); }

#define XB_TMO      128
#define XB_XCNT(j)  (256  + 64 * (j))
#define XB_XSUB(j)  (1280 + 64 * (j))
#define XB_XGEN(j)  (2304 + 64 * (j))
#define XB_TOP      3328
#define XB_TOPGEN   3392
#define XCD_BAR_WORDS 3456
#define XB_SPIN_CAP (1u << 18)

__device__ __forceinline__ unsigned xb_ld(unsigned* p)              { return __hip_atomic_load(p, __ATOMIC_RELAXED, __HIP_MEMORY_SCOPE_AGENT); }
__device__ __forceinline__ unsigned xb_add(unsigned* p, unsigned v) { return __hip_atomic_fetch_add(p, v, __ATOMIC_RELAXED, __HIP_MEMORY_SCOPE_AGENT); }
__device__ __forceinline__ unsigned xb_xcc_id() { return (unsigned)__builtin_amdgcn_s_getreg((3 << 11) | 20) & 0xFu; }
#define XB_SPIN(cond, bar) do { unsigned _sp = 0; while (cond) { __builtin_amdgcn_s_sleep(1); \
    if ((++_sp & 255u) == 0u) { if (xb_ld(&(bar)[XB_TMO])) break; if (_sp > XB_SPIN_CAP) { atomicAdd(&(bar)[XB_TMO], 1u); break; } } } } while (0)

struct XcdBarrier {
    unsigned* bar; unsigned x;
    volatile LAS unsigned* st;
};

__device__ __forceinline__ XcdBarrier xcd_barrier_post(unsigned* bar, volatile LAS unsigned* st) {
    XcdBarrier b; b.bar = bar; b.x = xb_xcc_id(); b.st = st;
    if (threadIdx.x == 0) (void)xb_add(&bar[XB_XCNT(b.x)], 1u);
    return b;
}
__device__ __forceinline__ void xcd_barrier_complete(unsigned* bar, unsigned x, unsigned& nloc, unsigned& nx) {
    const unsigned G = gridDim.x * gridDim.y * gridDim.z;
    unsigned sum, cnt, mine, sp = 0u;
    for (;;) {
        sum = 0u; cnt = 0u; mine = 0u;
#pragma unroll
        for (unsigned j = 0; j < 16; ++j) { const unsigned c = xb_ld(&bar[XB_XCNT(j)]); sum += c; cnt += (c > 0u) ? 1u : 0u; mine = (j == x) ? c : mine; }
        if (sum == G) break;
        __builtin_amdgcn_s_sleep(1);
        if ((++sp & 255u) == 0u) { if (xb_ld(&bar[XB_TMO])) break; if (sp > XB_SPIN_CAP) { atomicAdd(&bar[XB_TMO], 1u); break; } }
    }
    nloc = mine > 0u ? mine : 1u; nx = cnt > 0u ? cnt : 1u;
}

__device__ __forceinline__ void xcd_barrier(const XcdBarrier& b) {
    asm volatile("s_waitcnt vmcnt(0)" ::: "memory");
    __syncthreads();
    if (threadIdx.x == 0) {
        unsigned* bar = b.bar;
        __builtin_amdgcn_s_waitcnt(0);
        unsigned nloc = b.st[0], nx = b.st[1];
        if (nloc == 0u) { xcd_barrier_complete(bar, b.x, nloc, nx); b.st[0] = nloc; b.st[1] = nx; }
        const unsigned old = xb_add(&bar[XB_XSUB(b.x)], 1u);
        const unsigned gen = old / nloc;
        if (old + 1u == (gen + 1u) * nloc) {
            __builtin_amdgcn_fence(__ATOMIC_RELEASE, "agent");
            asm volatile("s_waitcnt vmcnt(0)" ::: "memory");
            const unsigned og = xb_add(&bar[XB_TOP], 1u);
            const unsigned tg = og / nx;
            if (og + 1u == (tg + 1u) * nx) xb_add(&bar[XB_TOPGEN], 1u);
            else XB_SPIN(xb_ld(&bar[XB_TOPGEN]) == tg, bar);
            __builtin_amdgcn_fence(__ATOMIC_ACQUIRE, "agent");
            xb_add(&bar[XB_XGEN(b.x)], 1u);
            asm volatile("s_waitcnt vmcnt(0)" ::: "memory");
        } else {
            XB_SPIN(xb_ld(&bar[XB_XGEN(b.x)]) == gen, bar);
            __builtin_amdgcn_fence(__ATOMIC_ACQUIRE, "agent");
            asm volatile("s_waitcnt vmcnt(0)" ::: "memory");
        }
    }
    __syncthreads();
}
namespace fox {
constexpr int D = 128, QP = 6144, KP = 6144, OP = 3072;
constexpr float THR = 8.f; constexpr bool WSKIP = false;
constexpr int NW = 8, QBLK = 32, KVBLK = 64, QB = NW * QBLK;
constexpr int SHM_V = KVBLK * D * 2, SHM_K = KVBLK * D * 2;
constexpr int LDS_WS = 2 * SHM_V + 2 * SHM_K, WS_STRIDE = 768;
constexpr int LDS_BYTES = LDS_WS + NW * WS_STRIDE;

using bf16 = __hip_bfloat16;
#define FOX_LAS __attribute__((address_space(3)))
typedef short bf16x8 __attribute__((ext_vector_type(8)));
typedef short s16x4 __attribute__((ext_vector_type(4)));
typedef float f32x16 __attribute__((ext_vector_type(16)));
typedef float f32x4 __attribute__((ext_vector_type(4)));
typedef unsigned u32x4 __attribute__((ext_vector_type(4)));
template <class A, class Bt> struct same_t { static constexpr bool v = false; };
template <class A> struct same_t<A, A> { static constexpr bool v = true; };

#define KSWZ(row, colB) ((row) * 256 + ((colB) ^ (((row) & 7) << 4)))
#define SBAR() __builtin_amdgcn_sched_barrier(0)
__device__ __forceinline__ int v_st(int k, int c) { const int kk = (k & ~0xC) | ((k & 4) << 1) | ((k & 8) >> 1); return ((kk >> 3) * 4 + (c >> 5)) * 512 + ((kk & 7) * 32 + (c & 31)) * 2; }
__device__ __forceinline__ int v_rd_base(int lane) { return ((lane & 3) << 3) | (((lane >> 2) & 3) << 6) | (((lane >> 4) & 1) << 5) | (((lane >> 5) & 1) << 8); }
constexpr int v_rd_off(int d0, int ks, int half) { return d0 * 512 + ks * 4096 + half * 2048; }
__device__ __forceinline__ int crow(int r, int hi) { return (r & 3) + 8 * (r >> 2) + 4 * hi; }
typedef float f32x2a_t __attribute__((ext_vector_type(2))); typedef __bf16 bf16x2a_t __attribute__((ext_vector_type(2)));
__device__ __forceinline__ unsigned cvtpk(float lo, float hi) {
    const f32x2a_t v = {lo, hi}; const bf16x2a_t b = __builtin_convertvector(v, bf16x2a_t); return __builtin_bit_cast(unsigned, b);
}
__device__ __forceinline__ bf16x8 pack8(f32x4 a, f32x4 b) {
    u32x4 w = {cvtpk(a[0], a[1]), cvtpk(a[2], a[3]), cvtpk(b[0], b[1]), cvtpk(b[2], b[3])};
    return *reinterpret_cast<bf16x8*>(&w);
}
template <class T> __device__ __forceinline__ bf16x8 load8(const T* p) {
    if constexpr (same_t<T, float>::v) { return pack8(*(const f32x4*)p, *(const f32x4*)(p + 4)); }
    else { return *reinterpret_cast<const bf16x8*>(p); }
}
__device__ __forceinline__ void mask_tile(f32x16& p0, f32x16& p1, int dq, unsigned W) {
    const float NEG = -__builtin_inff();
#pragma unroll
    for (int r = 0; r < 16; ++r) {
        const int c = (r & 3) + 8 * (r >> 2);
        if ((unsigned)(dq - c) >= W) p0[r] = NEG;
        if ((unsigned)(dq - c - 32) >= W) p1[r] = NEG;
    }
}
__device__ __forceinline__ void partialSM(f32x16& p0, f32x16& p1, float& m_reg, float& mn, float& alpha) {
    float pmax = p0[0]; for (int r = 1; r < 16; ++r) pmax = fmaxf(pmax, p0[r]); for (int r = 0; r < 16; ++r) pmax = fmaxf(pmax, p1[r]);
    { auto rr = __builtin_amdgcn_permlane32_swap(__float_as_uint(pmax), __float_as_uint(pmax), false, false);
      pmax = fmaxf(__uint_as_float(rr[0]), __uint_as_float(rr[1])); }
    if (__builtin_expect(__all((pmax - m_reg) <= THR), 1)) { mn = m_reg; alpha = 1.f; }
    else { mn = fmaxf(m_reg, pmax); alpha = __builtin_amdgcn_exp2f(m_reg - mn); m_reg = mn; }
    for (int r = 0; r < 16; ++r) p0[r] = p0[r] - mn; for (int r = 0; r < 16; ++r) p1[r] = p1[r] - mn;
    for (int r = 0; r < 16; ++r) p0[r] = __builtin_amdgcn_exp2f(p0[r]);
}
__device__ __forceinline__ void finishSM(f32x16& p0, f32x16& p1, float alpha, float& l_reg, bf16x8& pa0, bf16x8& pa1, bf16x8& pa2, bf16x8& pa3) {
    for (int r = 0; r < 16; ++r) p1[r] = __builtin_amdgcn_exp2f(p1[r]);
    float ps = 0; for (int r = 0; r < 16; ++r) ps += p0[r]; for (int r = 0; r < 16; ++r) ps += p1[r];
    { auto rr = __builtin_amdgcn_permlane32_swap(__float_as_uint(ps), __float_as_uint(ps), false, false);
      ps = __uint_as_float(rr[0]) + __uint_as_float(rr[1]); }
    l_reg = l_reg * alpha + ps;
#define PK4(P, B_, OUT) do { unsigned a0 = cvtpk(P[B_+0], P[B_+1]), a1 = cvtpk(P[B_+2], P[B_+3]);                          \
        unsigned b0 = cvtpk(P[B_+4], P[B_+5]), b1 = cvtpk(P[B_+6], P[B_+7]);                                             \
        auto r0 = __builtin_amdgcn_permlane32_swap(a0, b0, false, false); auto r1 = __builtin_amdgcn_permlane32_swap(a1, b1, false, false); \
        u32x4 w = {r0[0], r1[0], r0[1], r1[1]}; OUT = *reinterpret_cast<bf16x8*>(&w); } while (0)
    PK4(p0, 0, pa0); PK4(p0, 8, pa1); PK4(p1, 0, pa2); PK4(p1, 8, pa3);
#undef PK4
}
template <int KB, bool SK>
__device__ __forceinline__ void qkt(f32x16& p0, f32x16& p1, const char* K_lds, const char* F_lds, int r32, int hi, const bf16x8* qr, bool act) {
    if (SK && !act) { const float NEG = -__builtin_inff();
#pragma unroll
        for (int r = 0; r < 16; ++r) { p0[r] = NEG; p1[r] = NEG; } return; }
    { const float* fl = (const float*)(F_lds + KB * 256) + 4 * hi;
#pragma unroll
      for (int g_ = 0; g_ < 4; ++g_) { const f32x4 a = *(const f32x4*)(fl + 8 * g_), b = *(const f32x4*)(fl + 32 + 8 * g_);
          p0[4 * g_] = a[0]; p0[4 * g_ + 1] = a[1]; p0[4 * g_ + 2] = a[2]; p0[4 * g_ + 3] = a[3]; p1[4 * g_] = b[0]; p1[4 * g_ + 1] = b[1]; p1[4 * g_ + 2] = b[2]; p1[4 * g_ + 3] = b[3]; } }
    const char* kb[4];
#pragma unroll
    for (int dd = 0; dd < 4; ++dd) kb[dd] = K_lds + KB * SHM_K + KSWZ(r32, (dd * 16 + hi * 8) * 2);
#pragma unroll
    for (int d0 = 0; d0 < 8; ++d0) { const char* a = kb[d0 & 3] + (d0 >> 2) * 128;
        bf16x8 b0 = *reinterpret_cast<const bf16x8*>(a);
        bf16x8 b1 = *reinterpret_cast<const bf16x8*>(a + 32 * 256);
        p0 = __builtin_amdgcn_mfma_f32_32x32x16_bf16(b0, qr[d0], p0, 0, 0, 0);
        p1 = __builtin_amdgcn_mfma_f32_32x32x16_bf16(b1, qr[d0], p1, 0, 0, 0); }
}
template <int VB, bool SK>
__device__ __forceinline__ void pv_tile(f32x16* o, int vb0, bf16x8 pa0, bf16x8 pa1, bf16x8 pa2, bf16x8 pa3, bool act) {
    if (SK && !act) return;
#define TRRD(dst, off) asm volatile("ds_read_b64_tr_b16 %0, %1 offset:%2" : "=&v"(dst) : "v"(vb0), "i"(off) : "memory")
#define PV_D0(d0) do { s16x4 l0, l1, l2, l3, h0, h1, h2, h3; constexpr int b_ = VB * SHM_V + v_rd_off(d0, 0, 0);     \
        TRRD(l0, b_); TRRD(h0, b_ + 2048); TRRD(l1, b_ + 4096); TRRD(h1, b_ + 6144); TRRD(l2, b_ + 8192); TRRD(h2, b_ + 10240); TRRD(l3, b_ + 12288); TRRD(h3, b_ + 14336); \
        asm volatile("s_waitcnt lgkmcnt(0)" ::: "memory"); SBAR();                 \
        o[d0] = __builtin_amdgcn_mfma_f32_32x32x16_bf16(pa0, (bf16x8){l0[0], l0[1], l0[2], l0[3], h0[0], h0[1], h0[2], h0[3]}, o[d0], 0, 0, 0);   \
        o[d0] = __builtin_amdgcn_mfma_f32_32x32x16_bf16(pa1, (bf16x8){l1[0], l1[1], l1[2], l1[3], h1[0], h1[1], h1[2], h1[3]}, o[d0], 0, 0, 0);   \
        o[d0] = __builtin_amdgcn_mfma_f32_32x32x16_bf16(pa2, (bf16x8){l2[0], l2[1], l2[2], l2[3], h2[0], h2[1], h2[2], h2[3]}, o[d0], 0, 0, 0);   \
        o[d0] = __builtin_amdgcn_mfma_f32_32x32x16_bf16(pa3, (bf16x8){l3[0], l3[1], l3[2], l3[3], h3[0], h3[1], h3[2], h3[3]}, o[d0], 0, 0, 0); } while (0)
    PV_D0(0); PV_D0(1); PV_D0(2); PV_D0(3);
#undef PV_D0
#undef TRRD
}

template <class TIn, class TOut> struct BlockRef { const TIn* Q; const TIn* K; const TIn* V; TOut* O; const float* F; int P0, NT; float LH; };
__device__ __forceinline__ int fox_nt(const float* Fn, int P0, float lim) {
    int lane = threadIdx.x & 63; asm volatile("" : "+v"(lane));
    const int j_hi = P0 / KVBLK + QB / KVBLK;
    const float f0 = Fn[P0]; const bool in = lane < j_hi; const float v = in ? Fn[KVBLK * lane + KVBLK - 1] : 0.f;
    const unsigned long long need = __ballot(in && (f0 - v <= lim));
    const int j_stop = need ? (int)__builtin_ctzll(need) : 0;
    return j_hi - j_stop;
}
template <class TIn> struct Seam {
    bf16x8 qr[8];
    bf16x8 st_v0, st_v1, st_k0, st_k1; f32x4 sf0, sf1, sf2, sf3;
    float st_f;
    f32x4 tq[16];
};
__device__ __forceinline__ int swa_jlo(int P0, int W) { const int lowk = P0 - W + 1; return lowk > 0 ? lowk / KVBLK : 0; }
#define ROW(p, k0, rr) ((p) + (size_t)((k0) + (rr)) * KP + sc)
#define VMW() asm volatile("s_waitcnt vmcnt(0)" ::: "memory")
#define VMWN(n) asm volatile("s_waitcnt vmcnt(%0)" :: "i"(n) : "memory")
#define SLOAD_H(Kp, Vp, Fp, k0) do { S.st_v0 = load8<TIn>(ROW(Vp, k0, sr)); S.st_v1 = load8<TIn>(ROW(Vp, k0, 32 + sr));              \
                         S.st_k0 = load8<TIn>(ROW(Kp, k0, sr)); S.st_k1 = load8<TIn>(ROW(Kp, k0, 32 + sr)); S.st_f = (Fp)[(k0) + lane]; } while (0)
#define SWRITE_HK(bf) do { *(bf16x8*)(K_lds + (bf) * SHM_K + kws) = S.st_k0; *(bf16x8*)(K_lds + (bf) * SHM_K + kws + 32 * 256) = S.st_k1; ((float*)(F_lds + (bf) * 256))[lane] = S.st_f; } while (0)
#define SWRITE_HV(bf) do { *(bf16x8*)(V_lds + (bf) * SHM_V + vst0) = S.st_v0; *(bf16x8*)(V_lds + (bf) * SHM_V + vst1) = S.st_v1; } while (0)
#define SWRITE_H(bf) do { SWRITE_HV(bf); SWRITE_HK(bf); } while (0)
#define SLOAD_F(p, k0) do { S.sf0 = *(const f32x4*)ROW(p, k0, sr); S.sf1 = *(const f32x4*)(ROW(p, k0, sr) + 4);                \
                            S.sf2 = *(const f32x4*)ROW(p, k0, 32 + sr); S.sf3 = *(const f32x4*)(ROW(p, k0, 32 + sr) + 4); } while (0)
#define SWRITE_KF(bf) do { *(bf16x8*)(K_lds + (bf) * SHM_K + kws) = pack8(S.sf0, S.sf1); *(bf16x8*)(K_lds + (bf) * SHM_K + kws + 32 * 256) = pack8(S.sf2, S.sf3); } while (0)
#define SWRITE_VF(bf) do { *(bf16x8*)(V_lds + (bf) * SHM_V + vst0) = pack8(S.sf0, S.sf1); *(bf16x8*)(V_lds + (bf) * SHM_V + vst1) = pack8(S.sf2, S.sf3); } while (0)
template <class TIn, class TOut>
__device__ __forceinline__ void causal_swa_prime(const BlockRef<TIn, TOut>& cur, int W, char* lds, Seam<TIn>& S) {
    constexpr bool F32 = same_t<TIn, float>::v;
    const int tid = threadIdx.x, wid = __builtin_amdgcn_readfirstlane(tid >> 6), lane = tid & 63, r32 = lane & 31, hi = lane >> 5;
    const int sr = tid >> 4, sc = (tid & 15) * 8, kws = KSWZ(sr, sc * 2); char* K_lds = lds + 2 * SHM_V; char* F_lds = lds + LDS_WS + wid * WS_STRIDE + 256;
    const int kb0 = ((cur.P0 + QB - 1) / KVBLK) * KVBLK;
    for (int d0 = 0; d0 < 8; ++d0) S.qr[d0] = load8<TIn>(cur.Q + (size_t)(wid * QBLK + r32) * QP + d0 * 16 + hi * 8);
    if constexpr (F32) { SLOAD_F((const float*)cur.K, kb0); VMW(); SWRITE_KF(0); SBAR(); SLOAD_F((const float*)cur.V, kb0); }
    else { SLOAD_H(cur.K, cur.V, cur.F, kb0); VMW(); SWRITE_HK(0); }
    __syncthreads();
}
template <class TIn, class TOut>
__device__ __forceinline__ void causal_swa_block(const BlockRef<TIn, TOut>& cur, const BlockRef<TIn, TOut>& nxt, int skv, int W, char* lds, Seam<TIn>& S) {
    constexpr bool F32 = same_t<TIn, float>::v;
    const int tid = threadIdx.x, wid = __builtin_amdgcn_readfirstlane(tid >> 6), lane = tid & 63, r32 = lane & 31, hi = lane >> 5;
    int j_hi = (cur.P0 + QB - 1) / KVBLK + 1; if (j_hi > skv / KVBLK) j_hi = skv / KVBLK;
    int kcut = 0;
    int NT = cur.NT;
    const int kbn = ((nxt.P0 + QB - 1) / KVBLK) * KVBLK;
    const int qlo = cur.P0 + wid * QBLK, qm = qlo + r32 - 4 * hi;
    char* V_lds = lds; char* K_lds = lds + 2 * SHM_V;
    float* ws = (float*)(lds + LDS_WS + wid * WS_STRIDE); float* li_l = ws, * al_l = ws + 32; char* F_lds = (char*)(ws + 64);
    float m_reg = -1e30f, l_reg = 0; f32x16 o[4] = {};
    const int sr = tid >> 4, sc = (tid & 15) * 8, vst0 = v_st(sr, sc), vst1 = v_st(32 + sr, sc), kws = KSWZ(sr, sc * 2);
    const int vb0 = (int)(uintptr_t)V_lds + v_rd_base(lane);
    const TIn* Kh = cur.K; const TIn* Vh = cur.V; const float* Fh = cur.F;
#define RESC(a) do { if (__any((a) < 1.f)) { if (hi == 0) al_l[r32] = (a); asm volatile("s_waitcnt lgkmcnt(0)" ::: "memory");              \
                     for (int d_ = 0; d_ < 4; ++d_) for (int r = 0; r < 16; ++r) o[d_][r] *= al_l[crow(r, hi)]; } } while (0)
#define KBASE(t) ((j_hi - 1 - (t)) * KVBLK)
#define ACT(t) (KBASE(t) <= qlo + QBLK - 1 && KBASE(t) + KVBLK - 1 >= qlo - W + 1 && KBASE(t) >= kcut)
#define MASKT(P0_, P1_, t) do { const int kb_ = KBASE(t); if ((!SK || ACT(t)) && (kb_ + KVBLK - 1 > qlo || kb_ <= qlo + QBLK - 1 - W)) mask_tile(P0_, P1_, qm - kb_, (unsigned)W); } while (0)
    constexpr int NQL = F32 ? 16 : 8;
    constexpr bool SK = WSKIP && !F32;
#define SEAM_K0() do { VMWN(NQL); if constexpr (F32) { SWRITE_KF(0); SBAR(); SLOAD_F((const float*)nxt.V, kbn); } else { SWRITE_HK(0); } SBAR(); } while (0)
    f32x16 pA0, pA1, pB0, pB1; float mnA, mnB, alA, alB; bf16x8 pa0, pa1, pa2, pa3;
    if constexpr (F32) { VMW(); SWRITE_VF(0); SBAR(); } else { SWRITE_HV(0); SBAR(); }
    if (NT > 1) { if constexpr (F32) SLOAD_F((const float*)Kh, KBASE(1)); else SLOAD_H(Kh, Vh, Fh, KBASE(1)); }
    SBAR(); qkt<0, SK>(pA0, pA1, K_lds, F_lds, r32, hi, S.qr, ACT(0));
    if constexpr (F32) { if (NT > 1) { VMW(); SWRITE_KF(1); SBAR(); SLOAD_F((const float*)Vh, KBASE(1)); } }
    MASKT(pA0, pA1, 0); partialSM(pA0, pA1, m_reg, mnA, alA);
    if (NT > 1) { VMW(); if constexpr (F32) { SWRITE_VF(1); SBAR(); if (NT > 2) SLOAD_F((const float*)Kh, KBASE(2)); } else SWRITE_H(1); }
    __syncthreads();
#define HALF_STEP(PX0, PX1, mnX, alX, PY0, PY1, alY, t, KB, VB, SB) do {                                                      \
        SBAR(); qkt<KB, SK>(PX0, PX1, K_lds, F_lds, r32, hi, S.qr, ACT(t));                                             \
        finishSM(PY0, PY1, alY, l_reg, pa0, pa1, pa2, pa3); SBAR();                                                           \
        if ((t) + 1 < NT) { if constexpr (F32) { VMW(); SWRITE_KF(SB); SBAR(); SLOAD_F((const float*)Vh, KBASE((t) + 1)); }  \
                            else { SLOAD_H(Kh, Vh, Fh, KBASE((t) + 1)); } SBAR(); }                                               \
        pv_tile<VB, SK>(o, vb0, pa0, pa1, pa2, pa3, ACT((t) - 1)); MASKT(PX0, PX1, (t)); partialSM(PX0, PX1, m_reg, mnX, alX);                                        \
        __syncthreads();                                                                                                      \
        if ((t) + 1 < NT) { VMW(); if constexpr (F32) { SWRITE_VF(SB); SBAR(); if ((t) + 2 < NT) SLOAD_F((const float*)Kh, KBASE((t) + 2)); } \
                            else { SWRITE_H(SB); } }                                                                          \
        RESC(alX); __syncthreads(); } while (0)
    for (int t = 1; t + 1 < NT; t += 2) {
        if (t == 5) {
            int lv = 0;
            const float f0_ = Fh[cur.P0];
#pragma unroll
            for (int k_ = 0; k_ < 6; ++k_) lv += __all(m_reg - f0_ >= (float)(2 * k_ - 6)) ? 1 : 0;
            { int ln_ = threadIdx.x & 63; asm volatile("" : "+v"(ln_)); if (ln_ == 0) *(int*)al_l = lv; }
            __syncthreads();
#pragma unroll
            for (int w_ = 0; w_ < NW; ++w_) { const int o_ = __builtin_amdgcn_readfirstlane(*(const int*)(lds + LDS_WS + w_ * WS_STRIDE + 128)); lv = o_ < lv ? o_ : lv; }
            __syncthreads();
            { const float fw_ = Fh[qlo]; int lw = 0;
#pragma unroll
              for (int k_ = 0; k_ < 6; ++k_) lw += __all(m_reg - fw_ >= (float)(2 * k_ - 6)) ? 1 : 0;
              if (lw > 0) kcut = KVBLK * ((qlo / KVBLK + QB / KVBLK) - fox_nt(Fh, qlo, cur.LH - (float)(2 * lw - 8))); }
            if (lv > 0) { const int ntd = fox_nt(Fh, cur.P0, cur.LH - (float)(2 * lv - 8));
                const int ntm = ntd > t + 2 ? ntd : t + 2;
                NT = ntm < NT ? ntm : NT; }
        }
        HALF_STEP(pB0, pB1, mnB, alB, pA0, pA1, alA, t, 1, 0, 0);
        HALF_STEP(pA0, pA1, mnA, alA, pB0, pB1, alB, t + 1, 0, 1, 1);
    }
    int r32t = threadIdx.x & 31, hit = (threadIdx.x >> 5) & 1; asm volatile("" : "+v"(r32t), "+v"(hit));
    const bool even = (NT & 1) == 0;
    if (even) { SBAR(); qkt<1, SK>(pB0, pB1, K_lds, F_lds, r32, hi, S.qr, ACT(NT - 1)); SBAR(); }
#define QROW(e) (nxt.Q + (size_t)(wid * QBLK + r32) * QP + ((e) >> 1) * 16 + hi * 8 + ((e) & 1) * 4)
    if constexpr (F32) { SLOAD_F((const float*)nxt.K, kbn); SBAR();
#pragma unroll
        for (int e = 0; e < 8; ++e) S.tq[e] = *(const f32x4*)QROW(e); }
    else { SLOAD_H(nxt.K, nxt.V, nxt.F, kbn); SBAR();
#pragma unroll
        for (int d0 = 0; d0 < 8; ++d0) S.qr[d0] = load8<TIn>(nxt.Q + (size_t)(wid * QBLK + r32t) * QP + d0 * 16 + hit * 8); }
    SBAR();
    finishSM(pA0, pA1, alA, l_reg, pa0, pa1, pa2, pa3); SBAR();
    if constexpr (F32) {
#pragma unroll
        for (int e = 8; e < 16; ++e) S.tq[e] = *(const f32x4*)QROW(e); SBAR(); }
#undef QROW
    pv_tile<0, SK>(o, vb0, pa0, pa1, pa2, pa3, ACT(even ? NT - 2 : NT - 1));
    if (even) { MASKT(pB0, pB1, NT - 1); partialSM(pB0, pB1, m_reg, mnB, alB); __syncthreads(); RESC(alB);
        finishSM(pB0, pB1, alB, l_reg, pa0, pa1, pa2, pa3); SBAR(); pv_tile<1, SK>(o, vb0, pa0, pa1, pa2, pa3, ACT(NT - 1)); }
    SBAR(); SEAM_K0();
    if (hit == 0) li_l[r32t] = l_reg; asm volatile("s_waitcnt lgkmcnt(0)" ::: "memory");
    float rli[16];
#pragma unroll
    for (int r = 0; r < 16; ++r) rli[r] = __builtin_amdgcn_rcpf(li_l[crow(r, hit)]);
    TOut* Ow = cur.O + (size_t)(wid * QBLK) * OP;
#pragma unroll
    for (int r = 0; r < 16; ++r) { const int orow = crow(r, hit);
#pragma unroll
        for (int d0 = 0; d0 < 4; ++d0) { const float v = o[d0][r] * rli[r];
            if constexpr (same_t<TOut, float>::v) { Ow[(size_t)orow * OP + d0 * 32 + r32] = v; }
            else { const float vn = __shfl_xor(v, 1);
                   if ((r32t & 1) == 0) *(unsigned*)(Ow + (size_t)orow * OP + d0 * 32 + r32t) = cvtpk(v, vn); } } }
    if constexpr (F32) {
#pragma unroll
        for (int d0 = 0; d0 < 8; ++d0) S.qr[d0] = pack8(S.tq[2 * d0], S.tq[2 * d0 + 1]); }
    __syncthreads();
#undef RESC
#undef KBASE
#undef ACT
#undef MASKT
#undef SEAM_K0
#undef HALF_STEP
}
#undef ROW
#undef VMW
#undef VMWN
#undef SLOAD_H
#undef SWRITE_HK
#undef SWRITE_HV
#undef SWRITE_H
#undef SLOAD_F
#undef SWRITE_KF
#undef SWRITE_VF

}
constexpr int NWAVES = 8;
constexpr int BATCH = 4, SEQ = 4096, DM = 4096, M = BATCH * SEQ;
constexpr int NH = 16, HD = 128, FOXW = 2048, NQKV = 6144, S5W = 1024, NGATE = 8192, N1 = NQKV + S5W + NGATE;
constexpr int INCOLS = 15376, DFF = 11008, NGU = 2 * DFF, N1B = NQKV + S5W;
constexpr int S5G = 64, S5P = 64, S5C = 16, S5L = 32, S5K = S5C * S5L, S5NCH = SEQ / S5L;
constexpr int KQ = 2304, T_GU8 = KQ / 128, PAGU = KQ + 2 * (DM - KQ);
constexpr float RMS_EPS = 1e-6f;
constexpr float LOG2E = 1.4426950408889634f;
constexpr float QSCALE = 0.08838834764831845f * LOG2E;
enum { I_X = 0, I_GMIX, I_WIN, I_BF, I_BG, I_QN, I_KN, I_LRE, I_LIM, I_LSTEP, I_BRE, I_BIM, I_CRE, I_CIM, I_SD, I_WGLU, I_BGLU, I_WPF, I_WPS, I_WOUT, I_GFFN, I_WGU, I_WDN, N_IN };

constexpr size_t MiB = 1u << 20;
constexpr size_t WS_CTL = 0, CTL_ZERO_BYTES = 1 * MiB;
constexpr size_t WS_RS1 = 1 * MiB, WS_RS2 = WS_RS1 + 65536, WS_RSX = WS_RS1 + 131072, WS_SW = WS_RS1 + 196608, WS_SWO = WS_RS1 + 262144, WS_SAM = WS_RS1 + 327680;
constexpr size_t WS_SAH = WS_RS1 + 393216, WS_SBGU = WS_RS1 + 458752;
constexpr size_t WS_LS = 2 * MiB, WS_FK = 3 * MiB;
constexpr size_t WS_HP = 4 * MiB;
constexpr size_t WS_WF = 8 * MiB;
constexpr size_t WS_S5T = 9 * MiB;
constexpr size_t WS_W1 = 16 * MiB, WS_WGLU = 136 * MiB, WS_WPF = 138 * MiB, WS_WPS = 154 * MiB, WS_WO = 162 * MiB, WS_WGU = 194 * MiB, WS_WD = 366 * MiB;
constexpr size_t WS_RA = 452 * MiB;
constexpr size_t WS_RB = 580 * MiB;
constexpr size_t WS_WG8 = 16 * MiB;
constexpr size_t WS_QKV = 708 * MiB, WS_S5IN = 900 * MiB, WS_GATES = 932 * MiB, WS_ACT = 708 * MiB;
constexpr size_t WS_ATTN = 1188 * MiB, WS_G = 1284 * MiB;
constexpr int ASP = FOXW + S5W;
constexpr size_t WS_KT = 1316 * MiB, WS_ET = 1317 * MiB, WS_OM = 1325 * MiB, WS_LBL = 1333 * MiB, WS_END = 1334 * MiB;
static_assert(KQ % 256 == 0 && KQ >= 256 && KQ < DM && (size_t)M * DM * 2 <= WS_QKV - WS_RB, "mixed gate/up operand");
static_assert(WS_WG8 + (size_t)N1 * DM <= WS_WGLU && WS_WGU + (size_t)NGU * PAGU <= WS_WD && WS_WD + (size_t)DM * DFF * 2 <= WS_RA, "weights map");
static_assert(WS_ACT + (size_t)M * DFF * 2 <= WS_ATTN && WS_GATES + (size_t)M * NGATE * 2 <= WS_ATTN, "activation map");
constexpr int CW_TMO = 0, CW_ATTNQ = 1024, CW_BAR = 4096, CW_CMAX = 131072, CW_CMAXO = CW_CMAX + 16384, CW_CMAXGU = CW_CMAXO + 4096;

static_assert(N1 <= 16384 && (CW_CMAXGU + NGU) * 4 <= (int)CTL_ZERO_BYTES && WS_SBGU + (size_t)NGU * 4 <= WS_LS, "control words");
constexpr int RING_OFF = 0, RING_BYTES = 131072;
constexpr int LDSCTL_OFF = RING_BYTES, MISC_OFF = LDSCTL_OFF + 320;
constexpr int QKP_OFF = LDSCTL_OFF + 1024;
constexpr int LDS_BYTES = 147456;
static_assert(QKP_OFF + 8192 <= LDS_BYTES, "LDS map");

__device__ __forceinline__ float wave_sum(float v) {
#pragma unroll
    for (int o = 1; o < 64; o <<= 1) v += __shfl_xor(v, o);
    return v;
}
__device__ __forceinline__ float wave_max(float v) {
#pragma unroll
    for (int o = 1; o < 64; o <<= 1) v = fmaxf(v, __shfl_xor(v, o));
    return v;
}
__device__ __forceinline__ float gelu_tanh(float x) {
    const float u = x * x * (-2.0f * 0.7978845608028654f * 0.044715f * LOG2E) + (-2.0f * 0.7978845608028654f * LOG2E);
    return x * __builtin_amdgcn_rcpf(1.0f + __builtin_amdgcn_exp2f(u * x));
}
__device__ __forceinline__ float log_sigmoid_f(float v) { return fminf(v, 0.f) - log1pf(__expf(-fabsf(v))); }

__device__ __forceinline__ void p0_tr_item(const float* W, size_t ldw, int src_col, const float* kscale, bf16* WT, int K, int dst_row, int k0, LAS unsigned char* scr, int lane, int kdst = 0, const float* cmax = nullptr) {
    const int c = lane & 15, r = lane >> 4;
    const GAS float* src = (const GAS float*)W + (size_t)(k0 + 16 * r) * ldw + src_col + 4 * c;
    f32x4 v[16];
#pragma unroll
    for (int i = 0; i < 16; ++i) v[i] = __builtin_nontemporal_load((const GAS f32x4*)(src + (size_t)i * ldw));
    if (kscale) {
#pragma unroll
        for (int q = 0; q < 4; ++q) { const f32x4 sc = *(const GAS f32x4*)((const GAS float*)kscale + k0 + 16 * r + 4 * q);
            v[4 * q] = v[4 * q] * sc.x; v[4 * q + 1] = v[4 * q + 1] * sc.y; v[4 * q + 2] = v[4 * q + 2] * sc.z; v[4 * q + 3] = v[4 * q + 3] * sc.w; } }
    if (cmax) {
        f32x4 cm = *(const GAS f32x4*)((const GAS float*)cmax + dst_row + 4 * c);
#pragma unroll
        for (int j = 0; j < 4; ++j) cm[j] = 127.0f / (cm[j] > 0.f ? cm[j] : 1.0f);
#pragma unroll
        for (int i = 0; i < 16; ++i) v[i] = v[i] * cm; }
#pragma unroll
    for (int j = 0; j < 4; ++j)
#pragma unroll
        for (int h = 0; h < 2; ++h) { v4u o;
            o.x = pg8::cvt_pk_bf16(v[8 * h][j], v[8 * h + 1][j]); o.y = pg8::cvt_pk_bf16(v[8 * h + 2][j], v[8 * h + 3][j]);
            o.z = pg8::cvt_pk_bf16(v[8 * h + 4][j], v[8 * h + 5][j]); o.w = pg8::cvt_pk_bf16(v[8 * h + 6][j], v[8 * h + 7][j]);
            *(LAS v4u*)(scr + (4 * c + j) * 144 + (2 * r + h) * 16) = o; }
    LDS_WAIT(); asm volatile("" ::: "memory");
#pragma unroll
    for (int i = 0; i < 8; ++i) { const int n = (lane >> 3) + 8 * i; const v4u o = *(const LAS v4u*)(scr + n * 144 + (lane & 7) * 16);
        *(GAS v4u*)(WT + (size_t)(dst_row + n) * K + kdst + k0 + 8 * (lane & 7)) = o; }
    LDS_WAIT(); asm volatile("" ::: "memory");
}


__device__ __forceinline__ unsigned q8pack4(float a, float b, float c, float d) {
    return ((unsigned)(int)__builtin_rintf(a) & 0xffu) | (((unsigned)(int)__builtin_rintf(b) & 0xffu) << 8) | (((unsigned)(int)__builtin_rintf(c) & 0xffu) << 16) | ((unsigned)(int)__builtin_rintf(d) << 24);
}
__device__ __forceinline__ void p0_q8_item(const float* W, size_t ldw, int src_col, const float* kscale, const float* cmax, float* sw, signed char* WT, int K, int dst_row, int k0, LAS unsigned char* scr, int lane) {
    const int c = lane & 15, r = lane >> 4;
    const GAS float* src = (const GAS float*)W + (size_t)(k0 + 16 * r) * ldw + src_col + 4 * c;
    f32x4 v[16];
#pragma unroll
    for (int i = 0; i < 16; ++i) v[i] = __builtin_nontemporal_load((const GAS f32x4*)(src + (size_t)i * ldw));
    f32x4 cm = *(const GAS f32x4*)((const GAS float*)cmax + dst_row + 4 * c);
#pragma unroll
    for (int j = 0; j < 4; ++j) cm[j] = cm[j] > 0.f ? cm[j] : 1.0f;
    if (kscale) {
#pragma unroll
    for (int q = 0; q < 4; ++q) { const f32x4 sc = *(const GAS f32x4*)((const GAS float*)kscale + k0 + 16 * r + 4 * q);
        v[4 * q] = v[4 * q] * sc.x; v[4 * q + 1] = v[4 * q + 1] * sc.y; v[4 * q + 2] = v[4 * q + 2] * sc.z; v[4 * q + 3] = v[4 * q + 3] * sc.w; } }
#pragma unroll
    for (int j = 0; j < 4; ++j) { const float inv = 127.0f / cm[j]; v4u o;
        o.x = q8pack4(v[0][j] * inv, v[1][j] * inv, v[2][j] * inv, v[3][j] * inv); o.y = q8pack4(v[4][j] * inv, v[5][j] * inv, v[6][j] * inv, v[7][j] * inv);
        o.z = q8pack4(v[8][j] * inv, v[9][j] * inv, v[10][j] * inv, v[11][j] * inv); o.w = q8pack4(v[12][j] * inv, v[13][j] * inv, v[14][j] * inv, v[15][j] * inv);
        *(LAS v4u*)(scr + (4 * c + j) * 80 + r * 16) = o; }
    LDS_WAIT(); asm volatile("" ::: "memory");
#pragma unroll
    for (int i = 0; i < 4; ++i) { const int n = (lane >> 2) + 16 * i; const v4u o = *(const LAS v4u*)(scr + n * 80 + (lane & 3) * 16);
        *(GAS v4u*)(WT + (size_t)(dst_row + n) * K + k0 + 16 * (lane & 3)) = o; }
    if (k0 == 0 && r == 0) *(GAS f32x4*)((GAS float*)sw + dst_row + 4 * c) = cm * (1.0f / 127.0f);
    LDS_WAIT(); asm volatile("" ::: "memory");
}

#ifndef ATTN_NAIVE
#define ATTN_NAIVE 0
#endif
#ifndef S5_NAIVE
#define S5_NAIVE 0
#endif
#define PROBE_DUP -1
#define OUT_I8 0
#ifndef MK_ONE_LAUNCH
#define MK_ONE_LAUNCH 1
#endif
struct Args { const float* in[N_IN]; float* out; unsigned char* ws; int ph_lo, ph_hi, li, pad; };

__device__ __forceinline__ void sincos_small(float x, float& s, float& c) {
    const float k = rintf(x * 0.6366197723675814f);
    float r = fmaf(-k, 1.5707962512969971f, x); r = fmaf(-k, 7.549789415861596e-08f, r);
    const float r2 = r * r;
    const float sp = r + r * r2 * (-1.6666667e-1f + r2 * (8.3333333e-3f + r2 * (-1.9841270e-4f + r2 * 2.7557319e-6f)));
    const float cp = 1.0f + r2 * (-0.5f + r2 * (4.1666667e-2f + r2 * (-1.3888889e-3f + r2 * (2.4801587e-5f + r2 * -2.7557319e-7f))));
    const int q = ((int)k) & 3;
    s = (q == 0) ? sp : (q == 1) ? cp : (q == 2) ? -sp : -cp;
    c = (q == 0) ? cp : (q == 1) ? -sp : (q == 2) ? -cp : sp;
}
__device__ __forceinline__ void naive_s5_item(int b, int g, int p, const bf16* __restrict__ S5IN, const float* lam_re, const float* lam_im, const float* log_step, const float* b_re, const float* b_im,
                                               const float* c_re, const float* c_im, const float* dd, bf16* __restrict__ G) {
    const float lr = lam_re[g * 64 + p], li = lam_im[g * 64 + p], dt = __expf(log_step[g]);
    const float mag = __expf(lr * dt); float sn, cs; sincos_small(li * dt, sn, cs);
    const float lbr = mag * cs, lbi = mag * sn, den = lr * lr + li * li, nr = lbr - 1.0f;
    const float facr = (nr * lr + lbi * li) / den, faci = (lbi * lr - nr * li) / den;
    float Bbr[16], Bbi[16], Cr[16], Ci[16];
#pragma unroll
    for (int i = 0; i < 16; ++i) { const float br = b_re[(g * 64 + p) * 16 + i], bi = b_im[(g * 64 + p) * 16 + i];
        Bbr[i] = facr * br - faci * bi; Bbi[i] = facr * bi + faci * br; Cr[i] = c_re[(g * 16 + i) * 64 + p]; Ci[i] = c_im[(g * 16 + i) * 64 + p]; }
    const float dl = dd[g * 16 + (p & 15)];
    float xr = 0.f, xi = 0.f;
    for (int t = 0; t < SEQ; ++t) {
        const size_t ro = (size_t)(b * SEQ + t) * S5W + g * 16, ri = ((size_t)g * M + b * SEQ + t) * 16;
        const v4u w0 = *(const v4u*)(S5IN + ri), w1 = *(const v4u*)(S5IN + ri + 8);
        float u[16];
        u[0] = __uint_as_float(w0.x << 16); u[1] = __uint_as_float(w0.x & 0xffff0000u); u[2] = __uint_as_float(w0.y << 16); u[3] = __uint_as_float(w0.y & 0xffff0000u);
        u[4] = __uint_as_float(w0.z << 16); u[5] = __uint_as_float(w0.z & 0xffff0000u); u[6] = __uint_as_float(w0.w << 16); u[7] = __uint_as_float(w0.w & 0xffff0000u);
        u[8] = __uint_as_float(w1.x << 16); u[9] = __uint_as_float(w1.x & 0xffff0000u); u[10] = __uint_as_float(w1.y << 16); u[11] = __uint_as_float(w1.y & 0xffff0000u);
        u[12] = __uint_as_float(w1.z << 16); u[13] = __uint_as_float(w1.z & 0xffff0000u); u[14] = __uint_as_float(w1.w << 16); u[15] = __uint_as_float(w1.w & 0xffff0000u);
        float bur = 0.f, bui = 0.f;
#pragma unroll
        for (int i = 0; i < 16; ++i) { bur += Bbr[i] * u[i]; bui += Bbi[i] * u[i]; }
        const float nxr = lbr * xr - lbi * xi + bur, nxi = lbr * xi + lbi * xr + bui; xr = nxr; xi = nxi;
        float ysel = 0.f, usel = 0.f;
#pragma unroll
        for (int i = 0; i < 16; ++i) { const float tot = wave_sum(Cr[i] * xr - Ci[i] * xi); if ((p & 15) == i) { ysel = tot; usel = u[i]; } }
        const float y = ysel + dl * usel;
        if (p < 16) { const float gv = gelu_tanh(y); G[ro + p] = (bf16)f2bf(gv); }
    }
}


typedef float f32x2s __attribute__((ext_vector_type(2)));
__device__ __forceinline__ f32x2s cmul(f32x2s a, f32x2s b) { return (f32x2s){a.x * b.x - a.y * b.y, a.x * b.y + a.y * b.x}; }
__device__ __forceinline__ void s5_precompute(int g, const float* lam_re, const float* lam_im, const float* log_step, const float* b_re, const float* b_im, const float* c_re, const float* c_im, const float* dd,
                                              bf16* KT, bf16* ET, bf16* OM, float* LBL, LAS unsigned char* L) {
    LAS f32x2s* PW = (LAS f32x2s*)L;
    LAS f32x2s* BB = PW + 33 * 64;
    LAS f32x2s* CC = BB + 64 * 16;
    const int t = threadIdx.x;
    if (t < 64) { const int p = t;
        const float lr = lam_re[g * 64 + p], li = lam_im[g * 64 + p], dt = __expf(log_step[g]);
        const float mag = __expf(lr * dt); float sn, cs; sincos_small(li * dt, sn, cs);
        const f32x2s lb = {mag * cs, mag * sn}; const float den = lr * lr + li * li, nr = lb.x - 1.0f;
        const f32x2s fac = {(nr * lr + lb.y * li) / den, (lb.y * lr - nr * li) / den};
#pragma unroll 2
        for (int j = 0; j < 16; ++j) { const f32x2s bv = {b_re[(g * 64 + p) * 16 + j], b_im[(g * 64 + p) * 16 + j]}; BB[p * 16 + j] = cmul(fac, bv); }
#pragma unroll 2
        for (int i = 0; i < 16; ++i) CC[i * 64 + p] = (f32x2s){c_re[(g * 16 + i) * 64 + p], c_im[(g * 16 + i) * 64 + p]};
        f32x2s pw = {1.f, 0.f};
#pragma unroll 1
        for (int d = 0; d <= 32; ++d) { PW[d * 64 + p] = pw; pw = cmul(pw, lb); }
        const f32x2s l32 = PW[32 * 64 + p]; LBL[(g * 64 + p) * 2] = l32.x; LBL[(g * 64 + p) * 2 + 1] = l32.y;
    }
    __syncthreads();
    bf16* KTg = KT + (size_t)g * S5L * 256; bf16* ETg = ET + (size_t)g * 128 * S5K; bf16* OMg = OM + (size_t)g * S5K * 128;
#pragma unroll 1
    for (int idx = t; idx < S5L * 256; idx += NWAVES * 64) { const int d = idx >> 8, i = (idx >> 4) & 15, j = idx & 15; float a = 0.f;
#pragma unroll 4
        for (int p = 0; p < 64; ++p) { const f32x2s cp = cmul(CC[i * 64 + p], PW[d * 64 + p]), bv = BB[p * 16 + j]; a += cp.x * bv.x - cp.y * bv.y; }
        if (d == 0 && i == j) a += dd[g * 16 + i];
        KTg[idx] = (bf16)f2bf(a); }
#pragma unroll 2
    for (int idx = t; idx < 128 * S5K; idx += NWAVES * 64) { const int n = idx >> 9, k = idx & 511, p = n >> 1, sI = k >> 4, j = k & 15;
        const f32x2s v = cmul(PW[(31 - sI) * 64 + p], BB[p * 16 + j]); ETg[idx] = (bf16)f2bf((n & 1) ? v.y : v.x); }
#pragma unroll 2
    for (int idx = t; idx < S5K * 128; idx += NWAVES * 64) { const int row = idx >> 7, n = idx & 127, p = n >> 1, tt = row >> 4, i = row & 15;
        const f32x2s v = cmul(CC[i * 64 + p], PW[(tt + 1) * 64 + p]); OMg[idx] = (bf16)f2bf((n & 1) ? -v.y : v.x); }
    __syncthreads();
}

constexpr int S5_KTL_OFF = 65536 + 32768 + 4096 + 1024;
template <int T> __device__ __forceinline__ void s5_out_steps(const bf16x8 (&af)[16], const bf16x8 (&xf)[4], bf16x8 (&om)[4][4], const LAS unsigned char* kl, const bf16* op, bf16* gout, unsigned goff, int kq) {
    if constexpr (T < S5L) {
        if constexpr (T + 3 < S5L) {
#pragma unroll
            for (int ks = 0; ks < 4; ++ks) om[(T + 3) & 3][ks] = *(const bf16x8*)(op + (size_t)(T + 3) * 16 * 128 + 32 * ks); }
        f32x4 acc = {0.f, 0.f, 0.f, 0.f};
#pragma unroll
        for (int ks = 0; ks <= (T >> 1); ++ks) { const int d = T - 2 * ks;
            bf16x8 bfr = *(const LAS bf16x8*)(kl + d * 512);
            if (d == 0) { const bf16x8 zero8 = {0, 0, 0, 0, 0, 0, 0, 0}; bfr = (kq >> 1) ? zero8 : bfr; }
            acc = __builtin_amdgcn_mfma_f32_16x16x32_bf16(af[ks], bfr, acc, 0, 0, 0); }
#pragma unroll
        for (int ks = 0; ks < 4; ++ks) acc = __builtin_amdgcn_mfma_f32_16x16x32_bf16(xf[ks], om[T & 3][ks], acc, 0, 0, 0);
#pragma unroll
        for (int rg = 0; rg < 4; ++rg) { GAS bf16* gp = (GAS bf16*)gout + (size_t)(rg * S5L + T) * S5W; asm volatile("" : "+s"(gp)); gp[goff] = (bf16)f2bf(gelu_tanh(acc[rg])); }
        __builtin_amdgcn_sched_barrier(0);
        s5_out_steps<T + 1>(af, xf, om, kl, op, gout, goff, kq);
    }
}
template <int VAR> __device__ __forceinline__ void s5_item(int b, int g, const bf16* S5IN, const bf16* KT, const bf16* ET, const bf16* OM, const float* LBL, bf16* GO, LAS unsigned char* L, int wave) {
    const int lane = threadIdx.x & 63, fr = lane & 15, kq = lane >> 4;
    LAS float* EL = (LAS float*)L;
    LAS bf16* XIN = (LAS bf16*)(L + 65536);
    LAS f32x2s* PE = (LAS f32x2s*)(L + 65536 + 32768);
    const bf16* KTg = KT + (size_t)g * S5L * 256; const bf16* ETg = ET + (size_t)g * 128 * S5K; const bf16* OMg = OM + (size_t)g * S5K * 128;
    { const v4u* src = (const v4u*)KTg; LAS v4u* dst = (LAS v4u*)(L + S5_KTL_OFF);
      dst[threadIdx.x] = src[threadIdx.x]; dst[threadIdx.x + NWAVES * 64] = src[threadIdx.x + NWAVES * 64]; }
    const bf16* arow = S5IN + ((size_t)g * M + (size_t)b * SEQ + (size_t)(16 * wave + fr) * S5L) * 16;
    bf16x8 af[16];
#pragma unroll
    for (int ks = 0; ks < 16; ++ks) af[ks] = *(const bf16x8*)(arow + (2 * ks + (kq >> 1)) * 16 + 8 * (kq & 1));
    if constexpr (VAR != 2) {
#pragma unroll 2
    for (int nt = 0; nt < 8; ++nt) { f32x4 acc = {0.f, 0.f, 0.f, 0.f}; const bf16* bp = ETg + (size_t)(nt * 16 + fr) * S5K + 8 * kq;
#pragma unroll
        for (int ks = 0; ks < 16; ++ks) acc = __builtin_amdgcn_mfma_f32_16x16x32_bf16(af[ks], *(const bf16x8*)(bp + 32 * ks), acc, 0, 0, 0);
#pragma unroll
        for (int rg = 0; rg < 4; ++rg) EL[(16 * wave + 4 * kq + rg) * 128 + nt * 16 + fr] = acc[rg]; }
    }
    __syncthreads();
    { const int p = lane; const f32x2s lbl = {LBL[(g * 64 + p) * 2], LBL[(g * 64 + p) * 2 + 1]};
      f32x2s loc[16]; f32x2s x = {0.f, 0.f};
#pragma unroll
      for (int i = 0; i < 16; ++i) { const f32x2s e = *(const LAS f32x2s*)(EL + (16 * wave + i) * 128 + 2 * p); x = cmul(lbl, x); x.x += e.x; x.y += e.y; loc[i] = x; }
      PE[wave * 64 + p] = x;
      __syncthreads();
      f32x2s l16 = cmul(lbl, lbl); l16 = cmul(l16, l16); l16 = cmul(l16, l16); l16 = cmul(l16, l16);
      f32x2s cin = {0.f, 0.f};
      for (int q = 0; q < wave; ++q) { const f32x2s pe = PE[q * 64 + p]; cin = cmul(l16, cin); cin.x += pe.x; cin.y += pe.y; }
      f32x2s carry = cin, prev = {0.f, 0.f};
#pragma unroll
      for (int i = 0; i < 16; ++i) { const float xr = prev.x + carry.x, xi = prev.y + carry.y; *(LAS unsigned*)(XIN + (16 * wave + i) * 128 + 2 * p) = pk2(xr, xi); prev = loc[i]; carry = cmul(carry, lbl); }
    }
    __syncthreads();
    if constexpr (VAR == 1) { __syncthreads(); return; }
    bf16x8 xf[4];
#pragma unroll
    for (int ks = 0; ks < 4; ++ks) xf[ks] = *(const LAS bf16x8*)(XIN + (16 * wave + fr) * 128 + 32 * ks + 8 * kq);
    const LAS unsigned char* kl = L + S5_KTL_OFF + fr * 32 + 16 * (kq & 1) - 512 * (kq >> 1); const bf16* op = OMg + (size_t)fr * 128 + 8 * kq;
    bf16x8 om[4][4];
#pragma unroll
    for (int tt = 0; tt < 3; ++tt)
#pragma unroll
        for (int ks = 0; ks < 4; ++ks) om[tt][ks] = *(const bf16x8*)(op + (size_t)tt * 16 * 128 + 32 * ks);
    bf16* gout = GO + ((size_t)b * SEQ + (size_t)(16 * wave) * S5L) * S5W + g * 16; const unsigned goff = (unsigned)(4 * kq * S5L) * S5W + fr;
    s5_out_steps<0>(af, xf, om, kl, op, gout, goff, kq);
    __syncthreads();
}

__device__ __forceinline__ void naive_attn_item(const bf16* QKV, const float* FK, bf16* O, LAS float* sc, int item, int lane) {
    const int row = item >> 4, h = item & 15, b = row / SEQ, t = row % SEQ;
    const bf16* q = QKV + (size_t)row * NQKV + h * HD;
    const bf16* Kb = QKV + (size_t)b * SEQ * NQKV + FOXW + h * HD;
    const bf16* Vb = QKV + (size_t)b * SEQ * NQKV + 2 * FOXW + h * HD;
    const float* fk = FK + (size_t)(b * NH + h) * SEQ;
    float mx = -INFINITY;
    for (int j0 = 0; j0 <= t; j0 += 64) { const int j = j0 + lane;
        if (j <= t) { const bf16* kr = Kb + (size_t)j * NQKV; float s = 0.f;
            for (int c = 0; c < 16; ++c) { const v4u kw = *(const v4u*)(kr + c * 8), qw = *(const v4u*)(q + c * 8);
                s += __uint_as_float(kw.x << 16) * __uint_as_float(qw.x << 16) + __uint_as_float(kw.x & 0xffff0000u) * __uint_as_float(qw.x & 0xffff0000u);
                s += __uint_as_float(kw.y << 16) * __uint_as_float(qw.y << 16) + __uint_as_float(kw.y & 0xffff0000u) * __uint_as_float(qw.y & 0xffff0000u);
                s += __uint_as_float(kw.z << 16) * __uint_as_float(qw.z << 16) + __uint_as_float(kw.z & 0xffff0000u) * __uint_as_float(qw.z & 0xffff0000u);
                s += __uint_as_float(kw.w << 16) * __uint_as_float(qw.w << 16) + __uint_as_float(kw.w & 0xffff0000u) * __uint_as_float(qw.w & 0xffff0000u); }
            s += fk[j]; sc[j] = s; mx = fmaxf(mx, s); } }
    mx = wave_max(mx);
    LDS_WAIT(); asm volatile("" ::: "memory");
    float sum = 0.f;
    for (int j = lane; j <= t; j += 64) { const float p = exp2f(sc[j] - mx); sc[j] = p; sum += p; }
    sum = wave_sum(sum);
    LDS_WAIT(); asm volatile("" ::: "memory");
    float a0 = 0.f, a1 = 0.f;
    for (int j = 0; j <= t; ++j) { const float p = sc[j]; const unsigned vw = *(const unsigned*)(Vb + (size_t)j * NQKV + 2 * lane);
        a0 += p * __uint_as_float(vw << 16); a1 += p * __uint_as_float(vw & 0xffff0000u); }
    const float inv = 1.0f / sum;
    *(unsigned*)(O + (size_t)row * ASP + h * HD + 2 * lane) = pk2(a0 * inv, a1 * inv);
    LDS_WAIT(); asm volatile("" ::: "memory");
}

__global__ void __launch_bounds__(NWAVES * 64, 2) fwd(Args args) {
    extern __shared__ __attribute__((aligned(16))) unsigned char lds[];
    LAS unsigned char* L = (LAS unsigned char*)lds;
    volatile LAS unsigned* MISC = (volatile LAS unsigned*)(L + MISC_OFF);
    const int wave = __builtin_amdgcn_readfirstlane(threadIdx.x >> 6);
#define tid ((int)threadIdx.x)
#define LANE_DECL const int lane = threadIdx.x & 63
    const int G = gridDim.x, bx = blockIdx.x;
    const int vcu = (G % 8 == 0) ? (bx % 8) * (G / 8) + bx / 8 : bx;
    const int gw = vcu * NWAVES + wave, NGW = G * NWAVES;
    unsigned char* ws = args.ws;
    gu32* ctl = (gu32*)(ws + WS_CTL);
    for (int u = threadIdx.x; u < (LDS_BYTES - LDSCTL_OFF) / 4; u += NWAVES * 64) ((LAS unsigned*)(L + LDSCTL_OFF))[u] = 0u;
    __syncthreads();
    const int lo = args.ph_lo, hi = args.ph_hi;
    XcdBarrier bar; bar.bar = (unsigned*)(ctl + CW_BAR) + args.li * XCD_BAR_WORDS; bar.x = 0; bar.st = nullptr;
    if (hi - lo > 1 || lo == 0 || (lo <= 5 && 5 < hi)) bar = xcd_barrier_post((unsigned*)(ctl + CW_BAR) + args.li * XCD_BAR_WORDS, MISC + 8);
#define IN(k) (lo <= (k) && (k) < hi)
#define BOTH(k) (IN(k) && IN((k) + 1))
#define GRID_BAR() xcd_barrier(bar)

    const float* x = args.in[I_X];
    float* out = args.out;
    float* RS1 = (float*)(ws + WS_RS1); float* RS2 = (float*)(ws + WS_RS2); float* LS = (float*)(ws + WS_LS); float* FK = (float*)(ws + WS_FK); float* HP = (float*)(ws + WS_HP);
    bf16* WF = (bf16*)(ws + WS_WF); float* RSX = (float*)(ws + WS_RSX); float* SW = (float*)(ws + WS_SW);
    signed char* XQ = (signed char*)(ws + WS_RB); signed char* WG8 = (signed char*)(ws + WS_WG8); gu32* CMAX = ctl + CW_CMAX; gu32* CMAXO = ctl + CW_CMAXO;
    signed char* MQ = (signed char*)(ws + WS_RB); signed char* WO8 = (signed char*)(ws + WS_WO); float* SWO = (float*)(ws + WS_SWO); float* SAM = (float*)(ws + WS_SAM);
    bf16* WGLU = (bf16*)(ws + WS_WGLU); bf16* WCAT = (bf16*)(ws + WS_WPF);
    signed char* WGUX = (signed char*)(ws + WS_WGU); bf16* WD = (bf16*)(ws + WS_WD);
    signed char* AQ = (signed char*)(ws + WS_RB); float* SAH = (float*)(ws + WS_SAH); float* SBGU = (float*)(ws + WS_SBGU); gu32* CMAXGU = ctl + CW_CMAXGU;
    bf16* XB = (bf16*)(ws + WS_RA); bf16* HB = (bf16*)(ws + WS_RA); bf16* MERGED = (bf16*)(ws + WS_QKV);
    bf16* QKV = (bf16*)(ws + WS_QKV); bf16* S5IN = (bf16*)(ws + WS_S5IN); unsigned char* GATES = (unsigned char*)(ws + WS_GATES); bf16* ACT = (bf16*)(ws + WS_ACT);
    bf16* AS = (bf16*)(ws + WS_ATTN); bf16* GB = (bf16*)(ws + WS_G);
    bf16* KT = (bf16*)(ws + WS_KT); bf16* ET = (bf16*)(ws + WS_ET); bf16* OM = (bf16*)(ws + WS_OM); float* LBL = (float*)(ws + WS_LBL);

    if (IN(0)) {
        LANE_DECL;
        {
            constexpr int IA1 = (DM / 64) * (N1 / 64), IA2 = OUT_I8 ? (DM / 64) * (DM / 64) : 0, IA3 = (KQ / 64) * (NGU / 64);
            for (int it = gw; it < IA1 + IA2 + IA3; it += NGW) { const int kind = it < IA1 ? 0 : it < IA1 + IA2 ? 1 : 2; const int i2 = kind == 0 ? it : kind == 1 ? it - IA1 : it - IA1 - IA2, nbl = kind == 0 ? N1 / 64 : kind == 1 ? DM / 64 : NGU / 64,
                          kb = i2 / nbl, nb = i2 % nbl, c = lane & 15, r = lane >> 4, dr = 64 * nb;
                const size_t ldw = kind == 0 ? INCOLS : kind == 1 ? DM : NGU;
                const int scol = kind == 0 ? (dr < NQKV ? dr : dr + 16) : kind == 1 ? dr : ((dr & 255) < 128 ? 128 * (dr >> 8) + (dr & 255) : DFF + 128 * (dr >> 8) + ((dr & 255) - 128));
                const GAS float* src = (const GAS float*)(kind == 0 ? args.in[I_WIN] : kind == 1 ? args.in[I_WOUT] : args.in[I_WGU]) + (size_t)(64 * kb + 16 * r) * ldw + scol + 4 * c;
                f32x4 v[16];
#pragma unroll
                for (int i = 0; i < 16; ++i) v[i] = __builtin_nontemporal_load((const GAS f32x4*)(src + (size_t)i * ldw));
                f32x4 mx = {0.f, 0.f, 0.f, 0.f};
#pragma unroll
                for (int q = 0; q < 4; ++q) { f32x4 sc = {1.f, 1.f, 1.f, 1.f}; if (kind != 1) sc = *(const GAS f32x4*)((const GAS float*)(kind == 0 ? args.in[I_GMIX] : args.in[I_GFFN]) + 64 * kb + 16 * r + 4 * q);
                    mx = __builtin_elementwise_max(mx, __builtin_elementwise_abs(v[4 * q] * sc.x)); mx = __builtin_elementwise_max(mx, __builtin_elementwise_abs(v[4 * q + 1] * sc.y));
                    mx = __builtin_elementwise_max(mx, __builtin_elementwise_abs(v[4 * q + 2] * sc.z)); mx = __builtin_elementwise_max(mx, __builtin_elementwise_abs(v[4 * q + 3] * sc.w)); }
                gu32* cmx = (kind == 0 ? CMAX : kind == 1 ? CMAXO : CMAXGU) + dr + 4 * c;
#pragma unroll
                for (int j = 0; j < 4; ++j) { float m_ = mx[j]; m_ = fmaxf(m_, __shfl_xor(m_, 16)); m_ = fmaxf(m_, __shfl_xor(m_, 32));
                    if (r == 0) __hip_atomic_fetch_max(cmx + j, __float_as_uint(m_), RLX_AGENT); }
            }
        }
        GRID_BAR();
        for (int g = vcu; g < S5G; g += G)
            s5_precompute(g, args.in[I_LRE], args.in[I_LIM], args.in[I_LSTEP], args.in[I_BRE], args.in[I_BIM], args.in[I_CRE], args.in[I_CIM], args.in[I_SD], KT, ET, OM, LBL, L + RING_OFF);
        LAS unsigned char* scr = L + RING_OFF + wave * 16384;
        constexpr int IG8 = (DM / 64) * (N1 / 64), IGLU = (S5W / 64) * (S5W / 64), IPF = (FOXW / 64) * (DM / 64), IPS = (S5W / 64) * (DM / 64), IO = (DM / 64) * (DM / 64),
                      IGU = (DM / 64) * (NGU / 64);
        constexpr int NITEMS = IG8 + IGLU + IPF + IPS + IO + IGU;
        for (int idx = bx * (NWAVES * 64) + tid; idx < 16 * DM; idx += G * NWAVES * 64) { const int k = idx >> 4, h = idx & 15;
            WF[(size_t)h * DM + k] = (bf16)f2bf(args.in[I_WIN][(size_t)k * INCOLS + NQKV + h] * args.in[I_GMIX][k]); }
        for (int m = gw; m < M; m += NGW) {
            const GAS f32x4* xr = (const GAS f32x4*)(x + (size_t)m * DM) + lane;
            f32x4 v[16]; float s = 0.f;
#pragma unroll
            for (int j = 0; j < 16; ++j) { v[j] = __builtin_nontemporal_load(xr + 64 * j); s += (v[j].x * v[j].x + v[j].y * v[j].y) + (v[j].z * v[j].z + v[j].w * v[j].w); }
            const float tot = wave_sum(s);
            const float rs1 = 1.0f / sqrtf(tot * (1.0f / DM) + RMS_EPS);
            float ax = 0.f;
#pragma unroll
            for (int j = 0; j < 16; ++j) ax = fmaxf(ax, fmaxf(fmaxf(fabsf(v[j].x), fabsf(v[j].y)), fmaxf(fabsf(v[j].z), fabsf(v[j].w))));
            ax = wave_max(ax); const float qi = ax > 0.f ? 127.0f / ax : 0.f;
            if (lane == 0) { RS1[m] = rs1; RSX[m] = rs1 * ax * (1.0f / 127.0f); }
            GAS unsigned* q4 = (GAS unsigned*)(XQ + (size_t)m * DM) + lane;
#pragma unroll
            for (int j = 0; j < 16; ++j) q4[64 * j] = q8pack4(v[j].x * qi, v[j].y * qi, v[j].z * qi, v[j].w * qi);
            GAS unsigned long long* o8 = (GAS unsigned long long*)(XB + (size_t)m * DM) + lane;
#pragma unroll
            for (int j = 0; j < 16; ++j) o8[64 * j] = (unsigned long long)pk2(v[j].x, v[j].y) | ((unsigned long long)pk2(v[j].z, v[j].w) << 32);
        }
        for (int it = gw; it < NITEMS; it += NGW) {
            int r = it;
            if (r < IGU) { const int nblk = NGU / 64, kb = r / nblk, nb = r % nblk, dr = 64 * nb, t = dr >> 8, w = dr & 255;
                const int scol = w < 128 ? 128 * t + w : DFF + 128 * t + (w - 128);
                if (64 * kb < KQ) p0_q8_item(args.in[I_WGU], NGU, scol, args.in[I_GFFN], (const float*)CMAXGU, SBGU, WGUX, PAGU, dr, 64 * kb, scr, lane);
                else p0_tr_item(args.in[I_WGU], NGU, scol, args.in[I_GFFN], (bf16*)WGUX, PAGU / 2, dr, 64 * kb, scr, lane, -(KQ / 2), (const float*)CMAXGU);
                continue; } r -= IGU;
            if (r < IO) { const int nblk = DM / 64, kb = r / nblk, nb = r % nblk; p0_tr_item(args.in[I_WOUT], DM, 64 * nb, nullptr, (bf16*)WO8, DM, 64 * nb, 64 * kb, scr, lane); continue; } r -= IO;
            if (r < IPF) { const int nblk = DM / 64, kb = r / nblk, nb = r % nblk; p0_tr_item(args.in[I_WPF], DM, 64 * nb, nullptr, WCAT, ASP, 64 * nb, 64 * kb, scr, lane, 0); continue; } r -= IPF;
            if (r < IPS) { const int nblk = DM / 64, kb = r / nblk, nb = r % nblk; p0_tr_item(args.in[I_WPS], DM, 64 * nb, nullptr, WCAT, ASP, 64 * nb, 64 * kb, scr, lane, FOXW); continue; } r -= IPS;
            if (r < IGLU) { const int nblk = S5W / 64, kb = r / nblk, nb = r % nblk; p0_tr_item(args.in[I_WGLU], S5W, 64 * nb, nullptr, WGLU, S5W, 64 * nb, 64 * kb, scr, lane); continue; } r -= IGLU;
            { const int nblk = N1 / 64, kb = r / nblk, nb = r % nblk, dr = 64 * nb; p0_q8_item(args.in[I_WIN], INCOLS, dr < NQKV ? dr : dr + 16, args.in[I_GMIX], (const float*)CMAX, SW, WG8, DM, dr, 64 * kb, scr, lane); }
        }
        if (BOTH(0)) GRID_BAR();
    }

    if (IN(1)) {
        for (int it = vcu; it < M / 64; it += G) {
            LANE_DECL;
            const int r0 = it * 64 + (wave & 3) * 16, kh = (wave >> 2) * (DM / 2);
            const bf16* ap = XB + (size_t)(r0 + (lane & 15)) * DM + kh + 8 * (lane >> 4);
            const bf16* bp = WF + (size_t)(lane & 15) * DM + kh + 8 * (lane >> 4);
            f32x4 acc = {0.f, 0.f, 0.f, 0.f};
#pragma unroll 1
            for (int k0 = 0; k0 < DM / 2; k0 += 512) { bf16x8 a[16], b[16];
#pragma unroll
                for (int j = 0; j < 16; ++j) { a[j] = *(const bf16x8*)(ap + k0 + 32 * j); b[j] = *(const bf16x8*)(bp + k0 + 32 * j); }
#pragma unroll
                for (int j = 0; j < 16; ++j) acc = __builtin_amdgcn_mfma_f32_16x16x32_bf16(a[j], b[j], acc, 0, 0, 0); }
            LAS f32x4* px = (LAS f32x4*)(L + RING_OFF) + (wave & 3) * 64 + lane;
            if (wave >= 4) *px = acc;
            __syncthreads();
            if (wave < 4) { acc = acc + *px;
                const int h = lane & 15; const float bfg = args.in[I_BF][h];
#pragma unroll
                for (int rg = 0; rg < 4; ++rg) { const int row = r0 + 4 * (lane >> 4) + rg; LS[((size_t)(row >> 12) * NH + h) * SEQ + (row & (SEQ - 1))] = log_sigmoid_f(acc[rg] * RS1[row] + bfg); } }
            __syncthreads();
        }
        pg8::Gemm g{(const bf16*)XQ, (const bf16*)WG8, M, N1, DM / 2}; pg8::StaticOrder S; S.init(M, N1, G, bx);
        pg8::EpiZ E{QKV, S5IN, GATES, RSX, SW, args.in[I_BG], args.in[I_QN], args.in[I_KN], QSCALE, RMS_EPS, (LAS float*)(L + QKP_OFF)};
        pg8::gemm_phase<pg8::EpiZ, pg8::StaticOrder, true, true>(L + RING_OFF, g, S, E);
        if (BOTH(1)) GRID_BAR();
    }

    if (IN(2)) {
        LANE_DECL;
        if (gw < BATCH * NH) {
            const f32x4* base = (const f32x4*)(LS + (size_t)gw * SEQ + 64 * lane);
            f32x4 lv[16]; float s = 0.f;
#pragma unroll
            for (int i = 0; i < 16; ++i) lv[i] = base[i];
#pragma unroll
            for (int i = 0; i < 16; ++i) s += (lv[i].x + lv[i].y) + (lv[i].z + lv[i].w);
            float incl = s;
#pragma unroll
            for (int o = 1; o < 64; o <<= 1) { const float t = __shfl_up(incl, o); if (lane >= o) incl += t; }
            float run = incl - s;
            f32x4* fo = (f32x4*)(FK + (size_t)gw * SEQ + 64 * lane);
#pragma unroll
            for (int i = 0; i < 16; ++i) { f32x4 o; run += lv[i].x; o.x = -run * LOG2E; run += lv[i].y; o.y = -run * LOG2E; run += lv[i].z; o.z = -run * LOG2E; run += lv[i].w; o.w = -run * LOG2E; fo[i] = o; }
        }
#if !S5_NAIVE
        for (int it = vcu; it < BATCH * S5G; it += G) s5_item<0>(it & (BATCH - 1), it / BATCH, S5IN, KT, ET, OM, LBL, GB, L + RING_OFF, wave);
#else
        if (wave == 0) for (int it = vcu; it < BATCH * S5G; it += G)
            naive_s5_item(it >> 6, it & 63, lane, S5IN, args.in[I_LRE], args.in[I_LIM], args.in[I_LSTEP], args.in[I_BRE], args.in[I_BIM], args.in[I_CRE], args.in[I_CIM], args.in[I_SD], GB);
#endif
        if (BOTH(2)) GRID_BAR();
    }

    if (IN(3)) {
#if ATTN_NAIVE
        { LANE_DECL; LAS float* sc = (LAS float*)(L + RING_OFF + wave * 16384);
          for (int item = gw; item < M * NH; item += NGW) naive_attn_item(QKV, FK, AS, sc, item, lane); }
#else
        {
            typedef fox::BlockRef<fox::bf16, fox::bf16> BR;
            constexpr int NQB = SEQ / fox::QB, TOTAL = NQB * BATCH * NH;
            float lim;
            { const int ln = threadIdx.x & 63; float mq = fmaxf(fabsf(args.in[I_QN][ln]), fabsf(args.in[I_QN][ln + 64])), mk = fmaxf(fabsf(args.in[I_KN][ln]), fabsf(args.in[I_KN][ln + 64]));
              mq = wave_max(mq); mk = wave_max(mk); lim = 2.04f * (float)HD * QSCALE * mq * mk + 40.0f; }
            auto mkref = [&](int it) { const int qb = NQB - 1 - (it >> 6), bh = it & 63, b = bh / NH, h = bh % NH; BR r;
                r.Q = (const fox::bf16*)QKV + ((size_t)b * SEQ + (size_t)qb * fox::QB) * NQKV + h * HD;
                r.K = (const fox::bf16*)QKV + (size_t)b * SEQ * NQKV + FOXW + h * HD; r.V = (const fox::bf16*)QKV + (size_t)b * SEQ * NQKV + 2 * FOXW + h * HD;
                r.O = (fox::bf16*)AS + ((size_t)b * SEQ + (size_t)qb * fox::QB) * ASP + h * HD; r.F = FK + (size_t)bh * SEQ; r.P0 = qb * fox::QB; r.NT = fox::fox_nt(r.F, r.P0, lim); r.LH = 0.5f * (lim - 40.0f) + 40.0f; return r; };
            gu32* qctr = ctl + CW_ATTNQ + 64 * args.li;
            if (threadIdx.x == 0) { MISC[12] = __hip_atomic_fetch_add(qctr, 1u, RLX_AGENT); MISC[13] = __hip_atomic_fetch_add(qctr, 1u, RLX_AGENT); }
            __syncthreads();
            int ic = (int)MISC[12], in_ = (int)MISC[13], par = 0;
            __syncthreads();
            if (ic < TOTAL) {
                BR cur = mkref(ic); fox::Seam<fox::bf16> Sm;
                fox::causal_swa_prime<fox::bf16, fox::bf16>(cur, SEQ, (char*)lds + RING_OFF, Sm);
                for (;;) {
                    const bool last = in_ >= TOTAL;
                    if (threadIdx.x == 0 && !last) MISC[12 + par] = __hip_atomic_fetch_add(qctr, 1u, RLX_AGENT);
                    const BR nxt = last ? cur : mkref(in_);
                    fox::causal_swa_block<fox::bf16, fox::bf16>(cur, nxt, SEQ, SEQ, (char*)lds + RING_OFF, Sm);
                    if (last) break;
                    cur = nxt; in_ = (int)MISC[12 + par]; par ^= 1;
                }
            }
        }
#endif
    }

    if (IN(4)) {
        pg8::Gemm g{GB, WGLU, M, S5W, S5W}; pg8::StaticOrder S; S.init(M, S5W, G, bx);
        pg8::EpiGlu E{GB, AS + FOXW, args.in[I_BGLU], S5W, ASP};
        pg8::gemm_phase<pg8::EpiGlu, pg8::StaticOrder, true, true>(L + RING_OFF, g, S, E);
        if (BOTH(4)) GRID_BAR();
    }

    if (IN(5)) {
        pg8::Gemm g{AS, WCAT, M, DM, ASP}; pg8::StaticOrder S; S.init(M, DM, G, bx);
        typedef pg8::EpiProjT<OUT_I8 != 0> EpiP; EpiP E{GATES, NGATE, DM, MERGED, DM, HP};
        pg8::gemm_phase<EpiP, pg8::StaticOrder, false, true>(L + RING_OFF, g, S, E);
#if OUT_I8
        GRID_BAR();
        {
            LANE_DECL;
            for (int m = gw; m < M; m += NGW) {
                const float ax = wave_max(HP[(size_t)m * 64 + lane]) * 1.004f;
                const float qi = ax > 0.f ? 127.0f / ax : 0.f;
                if (lane == 0) SAM[m] = ax * (1.0f / 127.0f);
                const GAS v4u* src = (const GAS v4u*)(MERGED + (size_t)m * DM) + lane;
                GAS unsigned long long* dst = (GAS unsigned long long*)(MQ + (size_t)m * DM) + lane;
                v4u w[8];
#pragma unroll
                for (int j = 0; j < 8; ++j) w[j] = src[64 * j];
#pragma unroll
                for (int j = 0; j < 8; ++j) { const unsigned lo = q8pack4(pg8::bf_lo(w[j].x) * qi, pg8::bf_hi(w[j].x) * qi, pg8::bf_lo(w[j].y) * qi, pg8::bf_hi(w[j].y) * qi),
                                                             hi2 = q8pack4(pg8::bf_lo(w[j].z) * qi, pg8::bf_hi(w[j].z) * qi, pg8::bf_lo(w[j].w) * qi, pg8::bf_hi(w[j].w) * qi);
                    dst[64 * j] = (unsigned long long)lo | ((unsigned long long)hi2 << 32); }
            }
        }
#endif
        if (BOTH(5)) GRID_BAR();
    }

    if (IN(6)) {
#if OUT_I8
        pg8::Gemm g{(const bf16*)MQ, (const bf16*)WO8, M, DM, DM / 2}; pg8::StaticOrder S; S.init(M, DM, G, bx);
        typedef pg8::EpiResid<false, false, true, true> EpiH;
        EpiH E{x, nullptr, nullptr, HB, HP, DM, SAM, SWO};
#else
        pg8::Gemm g{MERGED, (const bf16*)WO8, M, DM, DM}; pg8::StaticOrder S; S.init(M, DM, G, bx);
        typedef pg8::EpiResid<false, false, true, false> EpiH;
        EpiH E{x, nullptr, nullptr, HB, HP, DM, nullptr, nullptr};
#endif
        pg8::gemm_phase<EpiH, pg8::StaticOrder, false, true>(L + RING_OFF, g, S, E);
        if (BOTH(6)) GRID_BAR();
    }

    if (IN(7)) {
        {
            LANE_DECL;
            constexpr int NCH = (KQ + 511) / 512, RB = 4;
            for (int m0 = gw; m0 < M; m0 += RB * NGW) {
                float hp[RB]; v4u w[RB][NCH];
#pragma unroll
                for (int r = 0; r < RB; ++r) { const int m = m0 + r * NGW; hp[r] = 0.f;
#pragma unroll
                    for (int j = 0; j < NCH; ++j) w[r][j] = (v4u){0u, 0u, 0u, 0u};
                    if (m < M) { hp[r] = HP[(size_t)m * 64 + lane]; const GAS v4u* src = (const GAS v4u*)(HB + (size_t)m * DM) + lane;
#pragma unroll
                        for (int j = 0; j < NCH; ++j) if (512 * j + 8 * lane < KQ) w[r][j] = src[64 * j]; } }
                asm volatile("" ::: "memory");
#pragma unroll
                for (int r = 0; r < RB; ++r) { const int m = m0 + r * NGW; if (m >= M) break;
                    const float ss = wave_sum(hp[r]);
                    float ax = 0.f;
#pragma unroll
                    for (int j = 0; j < NCH; ++j) ax = fmaxf(ax, fmaxf(fmaxf(fmaxf(fabsf(pg8::bf_lo(w[r][j].x)), fabsf(pg8::bf_hi(w[r][j].x))), fmaxf(fabsf(pg8::bf_lo(w[r][j].y)), fabsf(pg8::bf_hi(w[r][j].y)))),
                                                                           fmaxf(fmaxf(fabsf(pg8::bf_lo(w[r][j].z)), fabsf(pg8::bf_hi(w[r][j].z))), fmaxf(fabsf(pg8::bf_lo(w[r][j].w)), fabsf(pg8::bf_hi(w[r][j].w))))));
                    ax = wave_max(ax); ax = ax > 0.f ? ax : 1.0f; const float qi = 127.0f / ax;
                    if (lane == 0) { RS2[m] = 1.0f / sqrtf(ss * (1.0f / DM) + RMS_EPS); SAH[m] = ax * (1.0f / 127.0f); }
                    GAS unsigned long long* dst = (GAS unsigned long long*)(AQ + (size_t)m * (DM * 2)) + lane;
#pragma unroll
                    for (int j = 0; j < NCH; ++j) { const unsigned lo = q8pack4(pg8::bf_lo(w[r][j].x) * qi, pg8::bf_hi(w[r][j].x) * qi, pg8::bf_lo(w[r][j].y) * qi, pg8::bf_hi(w[r][j].y) * qi),
                                                                        hi2 = q8pack4(pg8::bf_lo(w[r][j].z) * qi, pg8::bf_hi(w[r][j].z) * qi, pg8::bf_lo(w[r][j].w) * qi, pg8::bf_hi(w[r][j].w) * qi);
                        if (512 * j + 8 * lane < KQ) dst[64 * j] = (unsigned long long)lo | ((unsigned long long)hi2 << 32); } }
            }
        }
        if (BOTH(7)) GRID_BAR();
    }

    if (IN(8)) {
        pg8::Gemm g{(const bf16*)AQ, (const bf16*)WGUX, M, NGU, PAGU / 2, DM, (const bf16*)((const char*)HB + KQ)}; pg8::StaticOrder S; S.init(M, NGU, G, bx);
        typedef pg8::EpiSwiGluT<T_GU8> EpiGU; EpiGU E{ACT, RS2, DFF, SAH, SBGU};
        pg8::gemm_phase<EpiGU, pg8::StaticOrder, true, true>(L + RING_OFF, g, S, E);
        {
            constexpr int NU = (M / 256) * (NGU / 256), ID = (DFF / 64) * (DM / 64); const int nshort = (NU % G) ? G - NU % G : G, first = (NU % G) ? NU % G : 0;
            if (bx >= first) { LANE_DECL; LAS unsigned char* scr = L + RING_OFF + wave * 16384;
                for (int it = (bx - first) * NWAVES + wave; it < ID; it += nshort * NWAVES) { const int nblk = DM / 64, kb = it / nblk, nb = it % nblk;
                    p0_tr_item(args.in[I_WDN], DM, 64 * nb, nullptr, WD, DFF, 64 * nb, 64 * kb, scr, lane); } }
        }
        if (BOTH(8)) GRID_BAR();
    }

    if (IN(9)) {
        pg8::Gemm g{ACT, WD, M, DM, DFF}; pg8::StaticOrder S; S.init(M, DM, G, bx, 2);
        typedef pg8::EpiResid<true, true, false> EpiY;
        EpiY E{nullptr, HB, out, nullptr, nullptr, DM, nullptr, nullptr};
        pg8::gemm_phase<EpiY, pg8::StaticOrder, false, true>(L + RING_OFF, g, S, E);
    }
#undef IN
#undef BOTH
#undef tid
#undef LANE_DECL
}

extern "C" void kernel_launch(void* const* d_in, const int* in_sizes, int n_in, void* d_out, int out_size, void* d_ws, size_t ws_size, hipStream_t stream) {
    static int grid = 0;
    if (grid == 0) {
        if (n_in != N_IN || in_sizes[0] != M * DM || out_size != M * DM || ws_size < WS_END) { fprintf(stderr, "kernel_launch: shape/workspace mismatch (n_in %d, in0 %d, out %d, ws %zu, need %zu)\n", n_in, n_in > 0 ? in_sizes[0] : -1, out_size, ws_size, (size_t)WS_END); grid = -1; return; }
        int dev = 0, cus = 0, per_cu = 0;
        if (hipGetDevice(&dev) != hipSuccess || hipDeviceGetAttribute(&cus, hipDeviceAttributeMultiprocessorCount, dev) != hipSuccess) { grid = -1; return; }
        if (hipFuncSetAttribute((const void*)fwd, hipFuncAttributeMaxDynamicSharedMemorySize, LDS_BYTES) != hipSuccess) { fprintf(stderr, "kernel_launch: hipFuncSetAttribute failed\n"); grid = -1; return; }
        if (hipOccupancyMaxActiveBlocksPerMultiprocessor(&per_cu, (const void*)fwd, NWAVES * 64, LDS_BYTES) != hipSuccess || per_cu < 1) fprintf(stderr, "kernel_launch: occupancy query says %d\n", per_cu);
        (void)hipGetLastError();
        grid = cus;
    }
    if (grid < 0) return;
    if (hipMemsetAsync((char*)d_ws + WS_CTL, 0, CTL_ZERO_BYTES, stream) != hipSuccess) return;
    Args a{};
    for (int i = 0; i < N_IN; ++i) a.in[i] = (const float*)d_in[i];
    a.out = (float*)d_out; a.ws = (unsigned char*)d_ws;
    unsigned char* ws = (unsigned char*)d_ws;
    int li = 0;
#define LAUNCH(lo_, hi_) do { a.ph_lo = (lo_); a.ph_hi = (hi_); a.li = li++; hipLaunchKernelGGL(fwd, dim3(grid), dim3(NWAVES * 64), LDS_BYTES, stream, a); } while (0)
#if MK_ONE_LAUNCH
    LAUNCH(0, 10);
#if PROBE_DUP >= 0
    LAUNCH(PROBE_DUP, PROBE_DUP + 1);
#endif
#else
    LAUNCH(0, 1); LAUNCH(1, 2); LAUNCH(2, 3); LAUNCH(3, 4); LAUNCH(4, 5); LAUNCH(5, 6); LAUNCH(6, 7); LAUNCH(7, 8); LAUNCH(8, 9); LAUNCH(9, 10);
#endif
#undef LAUNCH
    const hipError_t le = hipPeekAtLastError();
    if (le != hipSuccess) fprintf(stderr, "kernel_launch: launch failed: %s\n", hipGetErrorName(le));
}
```

```cpp
#include <hip/hip_runtime.h>
#include <hip/hip_bf16.h>
#include <cstdio>
#include <cstdint>
#include <cmath>
namespace pg8 {
#define PG8_LAS __attribute__((address_space(3)))
typedef unsigned short bf16_t;
typedef short bf16x8 __attribute__((ext_vector_type(8)));
typedef float f32x4 __attribute__((ext_vector_type(4)));
typedef unsigned u32x4 __attribute__((ext_vector_type(4)));
typedef int i32x4 __attribute__((ext_vector_type(4)));
__device__ __forceinline__ f32x4 pg8_mma(bf16x8 b, bf16x8 a, f32x4 c) { return __builtin_amdgcn_mfma_f32_16x16x32_bf16(b, a, c, 0, 0, 0); }
__device__ __forceinline__ i32x4 pg8_mma(bf16x8 b, bf16x8 a, i32x4 c) { return __builtin_amdgcn_mfma_i32_16x16x64_i8(__builtin_bit_cast(i32x4, b), __builtin_bit_cast(i32x4, a), c, 0, 0, 0); }
template <bool I8X> __device__ __forceinline__ f32x4 pg8_mma_x(bf16x8 b, bf16x8 a, f32x4 c) {
    if constexpr (I8X) return __builtin_bit_cast(f32x4, __builtin_amdgcn_mfma_i32_16x16x64_i8(__builtin_bit_cast(i32x4, b), __builtin_bit_cast(i32x4, a), __builtin_bit_cast(i32x4, c), 0, 0, 0));
    else return pg8_mma(b, a, c);
}
template <bool I8X> __device__ __forceinline__ i32x4 pg8_mma_x(bf16x8 b, bf16x8 a, i32x4 c) { return pg8_mma(b, a, c); }
__device__ __forceinline__ f32x4 pg8_zero(f32x4*) { return (f32x4){0.f, 0.f, 0.f, 0.f}; }
__device__ __forceinline__ i32x4 pg8_zero(i32x4*) { return (i32x4){0, 0, 0, 0}; }
constexpr int BM = 256, BK = 64, HALF = 128, HTB = HALF * BK * 2  , STAGE_BYTES = 8 * HTB, NXCD = 8, WGM = 8;

__host__ __device__ __forceinline__ int lds_byte(int r, int c) { const int st = (r >> 4) * 2 + (c >> 5), rr = r & 15, cc = c & 31, ob = rr * 64 + cc * 2; return st * 1024 + (ob ^ (((ob >> 9) & 1) << 5)); }
__host__ __device__ __forceinline__ void stage_rc(int b, int& R, int& C) { const int st = b / 1024, sb = b % 1024, swz = sb ^ (((sb >> 9) & 1) << 5); R = (st >> 1) * 16 + swz / 64; C = (st & 1) * 32 + (swz % 64) / 2; }
__host__ __device__ __forceinline__ int perm32(int rho) { const int n = rho >> 4, i = rho & 15; return 8 * (i >> 2) + 4 * n + (i & 3); }

struct Unit { int pm, pn; };
struct Gemm { const bf16_t* A; const bf16_t* Bt; int M, N, K; int KA; const bf16_t* A2; };

struct StaticOrder {
    int nM, nN, nwg, G, c, wgm;
    __host__ __device__ void init(int M, int N, int G_, int c_, int wgm_ = WGM) { nM = M / BM; nN = N / BM; nwg = nM * nN; G = G_; c = c_; wgm = wgm_; }
    __host__ __device__ bool next(int i, Unit& u) const {
        const long L = (long)i * G + c; if (L >= nwg) return false;
        int wgid = (int)L; { const int q = nwg / NXCD, r = nwg % NXCD, xcd = wgid % NXCD, off = wgid / NXCD; wgid = (xcd < r ? xcd * (q + 1) : r * (q + 1) + (xcd - r) * q) + off; }
        const int nig = wgm * nN, gid = wgid / nig, fm = gid * wgm, gsz = (nM - fm) < wgm ? (nM - fm) : wgm;
        u.pm = fm + ((wgid % nig) % gsz); u.pn = (wgid % nig) / gsz; return true;
    }
    __device__ __forceinline__ void a_ready(const Unit&) const {}
    __device__ __forceinline__ void done(const Unit&) const {}
};

typedef float f32x2c_t __attribute__((ext_vector_type(2))); typedef __bf16 bf16x2c_t __attribute__((ext_vector_type(2)));
__device__ __forceinline__ unsigned cvt_pk_bf16(float lo, float hi) { const f32x2c_t v = {lo, hi}; const bf16x2c_t b = __builtin_convertvector(v, bf16x2c_t); return __builtin_bit_cast(unsigned, b); }
typedef float f32x2 __attribute__((ext_vector_type(2)));
#define PG8_EPI_DRAIN() __builtin_amdgcn_s_waitcnt(0x0F70)
typedef unsigned u32x2 __attribute__((ext_vector_type(2)));
__device__ __forceinline__ unsigned gate_pack4(float a, float b, float c, float d) {
    unsigned r = __builtin_amdgcn_cvt_pk_u8_f32(a * 256.0f - 0.5f, 0, 0u); r = __builtin_amdgcn_cvt_pk_u8_f32(b * 256.0f - 0.5f, 1, r);
    r = __builtin_amdgcn_cvt_pk_u8_f32(c * 256.0f - 0.5f, 2, r); return __builtin_amdgcn_cvt_pk_u8_f32(d * 256.0f - 0.5f, 3, r);
}
__device__ __forceinline__ float gate_b0(unsigned w) { return (float)(w & 0xffu) + 0.5f; }
__device__ __forceinline__ float gate_b1(unsigned w) { return (float)((w >> 8) & 0xffu) + 0.5f; }
__device__ __forceinline__ float gate_b2(unsigned w) { return (float)((w >> 16) & 0xffu) + 0.5f; }
__device__ __forceinline__ float gate_b3(unsigned w) { return (float)(w >> 24) + 0.5f; }
__device__ __forceinline__ float sigmoid_f(float x) { return __builtin_amdgcn_rcpf(1.0f + __builtin_amdgcn_exp2f(-1.4426950408889634f * x)); }
__device__ __forceinline__ float bf_lo(unsigned w) { return __uint_as_float(w << 16); }
__device__ __forceinline__ float bf_hi(unsigned w) { return __uint_as_float(w & 0xffff0000u); }
__device__ __forceinline__ u32x4 pack8(const f32x4 v0, const f32x4 v1) { u32x4 w; w.x = cvt_pk_bf16(v0[0], v0[1]); w.y = cvt_pk_bf16(v0[2], v0[3]); w.z = cvt_pk_bf16(v1[0], v1[1]); w.w = cvt_pk_bf16(v1[2], v1[3]); return w; }

template <bool I8> struct acc_sel { typedef f32x4 t; }; template <> struct acc_sel<true> { typedef i32x4 t; };
__device__ __forceinline__ f32x4 to_f32(f32x4 a) { return a; }
__device__ __forceinline__ f32x4 to_f32(i32x4 a) { return __builtin_convertvector(a, f32x4); }
struct EpiZ {
    static constexpr bool PERM = true, AFTER_DRAIN = false; static constexpr int T_I8 = 0, MID_T = -1; typedef i32x4 acc_t;
    bf16_t* QKV; bf16_t* S5IN  ; unsigned char* GATES  ; const float* rs  ; const float* sw; const float* bg; const float* qn; const float* kn; float qscale, eps; PG8_LAS float* P;
    __device__ __forceinline__ void operator()(const i32x4 (&acc)[2][2][4][2], const Unit& u, int wr, int wc, int fr, int fq) const {
        const int row0 = u.pm * BM + wr * 64 + fr, colt = u.pn * BM + wc * 32 + 8 * fq;
        float rsv[2][4]; f32x4 sv[2][2];
#pragma unroll
        for (int ai = 0; ai < 2; ++ai)
#pragma unroll
            for (int m = 0; m < 4; ++m) rsv[ai][m] = rs[row0 + ai * HALF + m * 16];
#pragma unroll
        for (int bj = 0; bj < 2; ++bj)
#pragma unroll
            for (int n = 0; n < 2; ++n) sv[bj][n] = *(const f32x4*)(sw + colt + bj * HALF + 4 * n);
        if (u.pn < 16) {
            f32x4 w0, w1;
            { const float* wp = (u.pn < 8 ? qn : kn) + wc * 32 + 8 * fq; const float sc = u.pn < 8 ? qscale : 1.0f; w0 = *(const f32x4*)wp * sc; w1 = *(const f32x4*)(wp + 4) * sc; }
            asm volatile("" ::: "memory");
#pragma unroll
            for (int ai = 0; ai < 2; ++ai)
#pragma unroll
                for (int m = 0; m < 4; ++m) { const float s = rsv[ai][m];
#pragma unroll
                    for (int bj = 0; bj < 2; ++bj) { const f32x4 a = to_f32(acc[ai][bj][m][0]) * sv[bj][0] * s, b = to_f32(acc[ai][bj][m][1]) * sv[bj][1] * s;
                        float ss = (a[0] * a[0] + a[1] * a[1]) + (a[2] * a[2] + a[3] * a[3]) + (b[0] * b[0] + b[1] * b[1]) + (b[2] * b[2] + b[3] * b[3]);
                        ss += __shfl_xor(ss, 16); ss += __shfl_xor(ss, 32);
                        if (fq == 0) P[(ai * HALF + wr * 64 + m * 16 + fr) * 8 + bj * 4 + wc] = ss; } }
            asm volatile("s_waitcnt lgkmcnt(0)" ::: "memory"); __builtin_amdgcn_s_barrier(); asm volatile("" ::: "memory");
#pragma unroll
            for (int ai = 0; ai < 2; ++ai)
#pragma unroll
                for (int m = 0; m < 4; ++m) { const int r = row0 + ai * HALF + m * 16; bf16_t* rowp = QKV + (size_t)r * 6144 + colt;
#pragma unroll
                    for (int bj = 0; bj < 2; ++bj) { const f32x4 pp = *(const PG8_LAS f32x4*)(P + (ai * HALF + wr * 64 + m * 16 + fr) * 8 + bj * 4);
                        const float tot = (pp[0] + pp[1]) + (pp[2] + pp[3]); const float rr = rsv[ai][m] * __builtin_amdgcn_rsqf(tot * (1.0f / 128.0f) + eps);
                        const f32x4 v0 = to_f32(acc[ai][bj][m][0]) * sv[bj][0] * rr * w0, v1 = to_f32(acc[ai][bj][m][1]) * sv[bj][1] * rr * w1;
                        *(u32x4*)(rowp + bj * HALF) = pack8(v0, v1); } }
        } else if (u.pn >= 28) {
            const int col0 = colt - 28 * BM;
            f32x4 bv[2][2];
#pragma unroll
            for (int bj = 0; bj < 2; ++bj)
#pragma unroll
                for (int n = 0; n < 2; ++n) bv[bj][n] = *(const f32x4*)(bg + col0 + bj * HALF + 4 * n);
            asm volatile("" ::: "memory");
#pragma unroll
            for (int ai = 0; ai < 2; ++ai)
#pragma unroll
                for (int m = 0; m < 4; ++m) { const float s = rsv[ai][m]; unsigned char* rowp = GATES + (size_t)(row0 + ai * HALF + m * 16) * 8192 + col0;
#pragma unroll
                    for (int bj = 0; bj < 2; ++bj) { f32x4 v0 = to_f32(acc[ai][bj][m][0]) * sv[bj][0] * s + bv[bj][0], v1 = to_f32(acc[ai][bj][m][1]) * sv[bj][1] * s + bv[bj][1];
#pragma unroll
                        for (int e = 0; e < 4; ++e) { v0[e] = sigmoid_f(v0[e]); v1[e] = sigmoid_f(v1[e]); }
                        u32x2 o; o.x = gate_pack4(v0[0], v0[1], v0[2], v0[3]); o.y = gate_pack4(v1[0], v1[1], v1[2], v1[3]);
                        *(u32x2*)(rowp + bj * HALF) = o; } }
        } else if (u.pn >= 24) {
            const int col0 = colt - 24 * BM;
            asm volatile("" ::: "memory");
#pragma unroll
            for (int ai = 0; ai < 2; ++ai)
#pragma unroll
                for (int m = 0; m < 4; ++m) { const float s = rsv[ai][m]; const int r = row0 + ai * HALF + m * 16;
#pragma unroll
                    for (int bj = 0; bj < 2; ++bj) { const int col = col0 + bj * HALF;
                        *(u32x4*)(S5IN + ((size_t)(col >> 4) * (64 * BM) + r) * 16 + (col & 15)) = pack8(to_f32(acc[ai][bj][m][0]) * sv[bj][0] * s, to_f32(acc[ai][bj][m][1]) * sv[bj][1] * s); } }
        } else {
            asm volatile("" ::: "memory");
#pragma unroll
            for (int ai = 0; ai < 2; ++ai)
#pragma unroll
                for (int m = 0; m < 4; ++m) { const float s = rsv[ai][m]; bf16_t* rowp = QKV + (size_t)(row0 + ai * HALF + m * 16) * 6144 + colt;
#pragma unroll
                    for (int bj = 0; bj < 2; ++bj) *(u32x4*)(rowp + bj * HALF) = pack8(to_f32(acc[ai][bj][m][0]) * sv[bj][0] * s, to_f32(acc[ai][bj][m][1]) * sv[bj][1] * s); }
        }
        PG8_EPI_DRAIN();
    }
};
struct EpiGlu {
    static constexpr bool PERM = true, AFTER_DRAIN = false; static constexpr int T_I8 = 0, MID_T = -1; typedef f32x4 acc_t;
    const bf16_t* G; bf16_t* O; const float* bias; int ldc, ldo;
    __device__ __forceinline__ void operator()(const f32x4 (&acc)[2][2][4][2], const Unit& u, int wr, int wc, int fr, int fq) const {
        const int row0 = u.pm * BM + wr * 64 + fr, col0 = u.pn * BM + wc * 32 + 8 * fq;
        f32x4 bv[2][2];
#pragma unroll
        for (int bj = 0; bj < 2; ++bj)
#pragma unroll
            for (int n = 0; n < 2; ++n) bv[bj][n] = *(const f32x4*)(bias + col0 + bj * HALF + 4 * n);
        u32x4 gpre[2][4][2];
#pragma unroll
        for (int ai = 0; ai < 2; ++ai)
#pragma unroll
            for (int m = 0; m < 4; ++m)
#pragma unroll
                for (int bj = 0; bj < 2; ++bj) gpre[ai][m][bj] = *(const u32x4*)(G + (size_t)(row0 + ai * HALF + m * 16) * ldc + col0 + bj * HALF);
        asm volatile("" ::: "memory");
#pragma unroll
        for (int ai = 0; ai < 2; ++ai)
#pragma unroll
            for (int m = 0; m < 4; ++m) { const size_t offo = (size_t)(row0 + ai * HALF + m * 16) * ldo + col0;
#pragma unroll
                for (int bj = 0; bj < 2; ++bj) { const u32x4 gw = gpre[ai][m][bj];
                    f32x4 v0 = acc[ai][bj][m][0] + bv[bj][0], v1 = acc[ai][bj][m][1] + bv[bj][1];
                    v0[0] = bf_lo(gw.x) * sigmoid_f(v0[0]); v0[1] = bf_hi(gw.x) * sigmoid_f(v0[1]); v0[2] = bf_lo(gw.y) * sigmoid_f(v0[2]); v0[3] = bf_hi(gw.y) * sigmoid_f(v0[3]);
                    v1[0] = bf_lo(gw.z) * sigmoid_f(v1[0]); v1[1] = bf_hi(gw.z) * sigmoid_f(v1[1]); v1[2] = bf_lo(gw.w) * sigmoid_f(v1[2]); v1[3] = bf_hi(gw.w) * sigmoid_f(v1[3]);
                    *(u32x4*)(O + offo + bj * HALF) = pack8(v0, v1); } }
    }
};
template <bool MAXP> struct EpiProjT {
    static constexpr bool PERM = true, AFTER_DRAIN = false; static constexpr int T_I8 = 0, MID_T = 2048 / BK; typedef f32x4 acc_t;
    const unsigned char* gate  ; int ldg, goff; bf16_t* O; int ldc; float* mp;
    __device__ __forceinline__ void mid(f32x4 (&acc)[2][2][4][2], const Unit& u, int wr, int wc, int fr, int fq) const {
        int row0 = u.pm * BM + wr * 64 + fr, col0 = u.pn * BM + wc * 32 + 8 * fq;
        asm volatile("" : "+v"(row0), "+v"(col0));
        u32x2 fw[2][4][2], sw[2][4][2];
#pragma unroll
        for (int ai = 0; ai < 2; ++ai)
#pragma unroll
            for (int m = 0; m < 4; ++m) { const size_t goffs = (size_t)(row0 + ai * HALF + m * 16) * ldg + col0;
#pragma unroll
                for (int bj = 0; bj < 2; ++bj) { fw[ai][m][bj] = *(const u32x2*)(gate + goffs + bj * HALF); sw[ai][m][bj] = *(const u32x2*)(gate + goffs + goff + bj * HALF); } }
        asm volatile("" ::: "memory");
#pragma unroll
        for (int ai = 0; ai < 2; ++ai)
#pragma unroll
            for (int m = 0; m < 4; ++m)
#pragma unroll
                for (int bj = 0; bj < 2; ++bj) { const u32x2 f = fw[ai][m][bj], g = sw[ai][m][bj];
                    f32x4& v0 = acc[ai][bj][m][0]; f32x4& v1 = acc[ai][bj][m][1];
                    v0[0] *= gate_b0(f.x) * __builtin_amdgcn_rcpf(gate_b0(g.x)); v0[1] *= gate_b1(f.x) * __builtin_amdgcn_rcpf(gate_b1(g.x));
                    v0[2] *= gate_b2(f.x) * __builtin_amdgcn_rcpf(gate_b2(g.x)); v0[3] *= gate_b3(f.x) * __builtin_amdgcn_rcpf(gate_b3(g.x));
                    v1[0] *= gate_b0(f.y) * __builtin_amdgcn_rcpf(gate_b0(g.y)); v1[1] *= gate_b1(f.y) * __builtin_amdgcn_rcpf(gate_b1(g.y));
                    v1[2] *= gate_b2(f.y) * __builtin_amdgcn_rcpf(gate_b2(g.y)); v1[3] *= gate_b3(f.y) * __builtin_amdgcn_rcpf(gate_b3(g.y)); }
    }
    __device__ __forceinline__ void operator()(const f32x4 (&acc)[2][2][4][2], const Unit& u, int wr, int wc, int fr, int fq) const {
        const int row0 = u.pm * BM + wr * 64 + fr, col0 = u.pn * BM + wc * 32 + 8 * fq;
        u32x2 gpre[2][4][2];
#pragma unroll
        for (int ai = 0; ai < 2; ++ai)
#pragma unroll
            for (int m = 0; m < 4; ++m)
#pragma unroll
                for (int bj = 0; bj < 2; ++bj) gpre[ai][m][bj] = *(const u32x2*)(gate + (size_t)(row0 + ai * HALF + m * 16) * ldg + col0 + goff + bj * HALF);
        asm volatile("" ::: "memory");
#pragma unroll
        for (int ai = 0; ai < 2; ++ai)
#pragma unroll
            for (int m = 0; m < 4; ++m) { const int r = row0 + ai * HALF + m * 16; const size_t off = (size_t)r * ldc + col0; float mx = 0.f;
#pragma unroll
                for (int bj = 0; bj < 2; ++bj) { const u32x2 gw = gpre[ai][m][bj]; constexpr float q = 1.0f / 256.0f;
                    f32x4 v0 = acc[ai][bj][m][0], v1 = acc[ai][bj][m][1];
                    v0[0] *= gate_b0(gw.x) * q; v0[1] *= gate_b1(gw.x) * q; v0[2] *= gate_b2(gw.x) * q; v0[3] *= gate_b3(gw.x) * q;
                    v1[0] *= gate_b0(gw.y) * q; v1[1] *= gate_b1(gw.y) * q; v1[2] *= gate_b2(gw.y) * q; v1[3] *= gate_b3(gw.y) * q;
                    if constexpr (MAXP) { const f32x4 a0 = __builtin_elementwise_abs(v0), a1 = __builtin_elementwise_abs(v1);
                    mx = fmaxf(mx, fmaxf(fmaxf(fmaxf(a0[0], a0[1]), fmaxf(a0[2], a0[3])), fmaxf(fmaxf(a1[0], a1[1]), fmaxf(a1[2], a1[3])))); }
                    *(u32x4*)(O + off + bj * HALF) = pack8(v0, v1); }
                if constexpr (MAXP) { mx = fmaxf(mx, __shfl_xor(mx, 16)); mx = fmaxf(mx, __shfl_xor(mx, 32)); if (fq == 0) mp[(size_t)r * 64 + u.pn * 4 + wc] = mx; } }
    }
};
typedef EpiProjT<true> EpiProj;
template <bool BASE16, bool OUT, bool HB, bool I8 = false> struct EpiResid {
    static constexpr bool PERM = false, AFTER_DRAIN = false; static constexpr int T_I8 = 0, MID_T = -1; typedef typename acc_sel<I8>::t acc_t;
    const float* base; const bf16_t* base16; float* out; bf16_t* hb; float* hp; int ldc; const float* sa; const float* sb;
    __device__ __forceinline__ void operator()(const acc_t (&acc)[2][2][4][2], const Unit& u, int wr, int wc, int fr, int fq) const {
        typedef unsigned u32x2v __attribute__((ext_vector_type(2)));
        const int row0 = u.pm * BM + wr * 64 + fr, col0 = u.pn * BM + wc * 32 + 4 * fq;
        f32x4 sbv[2][2];
        if constexpr (I8) {
#pragma unroll
            for (int bj = 0; bj < 2; ++bj)
#pragma unroll
                for (int n = 0; n < 2; ++n) sbv[bj][n] = *(const f32x4*)(sb + col0 + bj * HALF + n * 16); }
        u32x2v raw[2][4][2][2];
        if constexpr (BASE16) {
#pragma unroll
            for (int ai = 0; ai < 2; ++ai)
#pragma unroll
                for (int m = 0; m < 4; ++m) { const size_t off = (size_t)(row0 + ai * HALF + m * 16) * ldc + col0;
#pragma unroll
                    for (int bj = 0; bj < 2; ++bj)
#pragma unroll
                        for (int n = 0; n < 2; ++n) raw[ai][m][bj][n] = *(const u32x2v*)(base16 + off + bj * HALF + n * 16); }
            asm volatile("" ::: "memory"); }
#pragma unroll
        for (int ai = 0; ai < 2; ++ai) {
            f32x4 pre[4][2][2];
            float sav[4];
            if constexpr (I8) {
#pragma unroll
                for (int m = 0; m < 4; ++m) sav[m] = sa[row0 + ai * HALF + m * 16]; }
#pragma unroll
            for (int m = 0; m < 4; ++m) { const size_t off = (size_t)(row0 + ai * HALF + m * 16) * ldc + col0;
#pragma unroll
                for (int bj = 0; bj < 2; ++bj)
#pragma unroll
                    for (int n = 0; n < 2; ++n) {
                        if constexpr (BASE16) { const u32x2v bw = raw[ai][m][bj][n]; pre[m][bj][n] = (f32x4){bf_lo(bw.x), bf_hi(bw.x), bf_lo(bw.y), bf_hi(bw.y)}; }
                        else pre[m][bj][n] = *(const f32x4*)(base + off + bj * HALF + n * 16); } }
            asm volatile("" ::: "memory");
#pragma unroll
            for (int m = 0; m < 4; ++m) { const int r = row0 + ai * HALF + m * 16; const size_t off = (size_t)r * ldc + col0; float ss = 0.f;
#pragma unroll
                for (int bj = 0; bj < 2; ++bj)
#pragma unroll
                    for (int n = 0; n < 2; ++n) { f32x4 o;
                        if constexpr (I8) o = pre[m][bj][n] + to_f32(acc[ai][bj][m][n]) * sbv[bj][n] * sav[m]; else o = pre[m][bj][n] + to_f32(acc[ai][bj][m][n]);
                        if constexpr (OUT) *(f32x4*)(out + off + bj * HALF + n * 16) = o;
                        if constexpr (HB) { u32x2v w; w.x = cvt_pk_bf16(o[0], o[1]); w.y = cvt_pk_bf16(o[2], o[3]); *(u32x2v*)(hb + off + bj * HALF + n * 16) = w;
                                  ss += (o[0] * o[0] + o[1] * o[1]) + (o[2] * o[2] + o[3] * o[3]); } }
                if constexpr (HB) { ss += __shfl_xor(ss, 16); ss += __shfl_xor(ss, 32); if (fq == 0) hp[(size_t)r * 64 + u.pn * 4 + wc] = ss; } }
            asm volatile("" ::: "memory");
        }
    }
};
template <int TI8> struct EpiSwiGluT {
    static constexpr bool PERM = true, AFTER_DRAIN = false; static constexpr int T_I8 = TI8, MID_T = -1; typedef f32x4 acc_t;
    bf16_t* O; const float* rs; int ldc; const float* sa; const float* sb;
    struct Pre { float sv[2][4], rsv[2][4]; f32x4 cg[2], cu[2]; };
    __device__ __forceinline__ void pre(Pre& p, const Unit& u, int wr, int wc, int fr, int fq) const {
        const int row0 = u.pm * BM + wr * 64 + fr;
#pragma unroll
        for (int ai = 0; ai < 2; ++ai)
#pragma unroll
            for (int m = 0; m < 4; ++m) { p.sv[ai][m] = sa[row0 + ai * HALF + m * 16]; p.rsv[ai][m] = rs[row0 + ai * HALF + m * 16]; }
        const float* sp = sb + u.pn * BM + wc * 32 + 8 * fq;
        p.cg[0] = *(const f32x4*)sp; p.cg[1] = *(const f32x4*)(sp + 4); p.cu[0] = *(const f32x4*)(sp + HALF); p.cu[1] = *(const f32x4*)(sp + HALF + 4);
    }
    __device__ __forceinline__ void mid(f32x4 (&acc)[2][2][4][2], const Pre& p) const {
#pragma unroll
        for (int ai = 0; ai < 2; ++ai)
#pragma unroll
            for (int m = 0; m < 4; ++m)
#pragma unroll
                for (int bj = 0; bj < 2; ++bj)
#pragma unroll
                    for (int n = 0; n < 2; ++n) acc[ai][bj][m][n] = __builtin_convertvector(__builtin_bit_cast(i32x4, acc[ai][bj][m][n]), f32x4) * p.sv[ai][m];
    }
    __device__ __forceinline__ void operator()(const f32x4 (&acc)[2][2][4][2], const Unit& u, int wr, int wc, int fr, int fq, const Pre& p) const {
        const int row0 = u.pm * BM + wr * 64 + fr, col0 = u.pn * HALF + wc * 32 + 8 * fq;
#pragma unroll
        for (int ai = 0; ai < 2; ++ai)
#pragma unroll
            for (int m = 0; m < 4; ++m) { const int r = row0 + ai * HALF + m * 16; const float s = p.rsv[ai][m];
                f32x4 g0 = acc[ai][0][m][0] * s * p.cg[0], g1 = acc[ai][0][m][1] * s * p.cg[1]; const f32x4 u0 = acc[ai][1][m][0] * s * p.cu[0], u1 = acc[ai][1][m][1] * s * p.cu[1];
#pragma unroll
                for (int e = 0; e < 4; ++e) { g0[e] = g0[e] * sigmoid_f(g0[e]) * u0[e]; g1[e] = g1[e] * sigmoid_f(g1[e]) * u1[e]; }
                *(u32x4*)(O + (size_t)r * ldc + col0) = pack8(g0, g1); }
    }
};
typedef EpiSwiGluT<0> EpiSwiGlu;


template <bool BASE16, bool OUT, bool HB> struct EpiResidP {
    static constexpr bool PERM = true, AFTER_DRAIN = false; static constexpr int T_I8 = 0, MID_T = -1; typedef f32x4 acc_t;
    const float* base; const bf16_t* base16; float* out; bf16_t* hb; float* hp; int ldc;
    __device__ __forceinline__ void operator()(const f32x4 (&acc)[2][2][4][2], const Unit& u, int wr, int wc, int fr, int fq) const {
        const int row0 = u.pm * BM + wr * 64 + fr, col0 = u.pn * BM + wc * 32 + 8 * fq;
        u32x4 raw[2][4][2];
        if constexpr (BASE16) {
#pragma unroll
            for (int ai = 0; ai < 2; ++ai)
#pragma unroll
                for (int m = 0; m < 4; ++m)
#pragma unroll
                    for (int bj = 0; bj < 2; ++bj) raw[ai][m][bj] = *(const u32x4*)(base16 + (size_t)(row0 + ai * HALF + m * 16) * ldc + col0 + bj * HALF);
            asm volatile("" ::: "memory"); }
#pragma unroll
        for (int ai = 0; ai < 2; ++ai) {
            f32x4 pre[4][2][2];
#pragma unroll
            for (int m = 0; m < 4; ++m) { const size_t off = (size_t)(row0 + ai * HALF + m * 16) * ldc + col0;
#pragma unroll
                for (int bj = 0; bj < 2; ++bj) {
                    if constexpr (BASE16) { const u32x4 bw = raw[ai][m][bj]; pre[m][bj][0] = (f32x4){bf_lo(bw.x), bf_hi(bw.x), bf_lo(bw.y), bf_hi(bw.y)}; pre[m][bj][1] = (f32x4){bf_lo(bw.z), bf_hi(bw.z), bf_lo(bw.w), bf_hi(bw.w)}; }
                    else { pre[m][bj][0] = *(const f32x4*)(base + off + bj * HALF); pre[m][bj][1] = *(const f32x4*)(base + off + bj * HALF + 4); } } }
            asm volatile("" ::: "memory");
#pragma unroll
            for (int m = 0; m < 4; ++m) { const int r = row0 + ai * HALF + m * 16; const size_t off = (size_t)r * ldc + col0; float ss = 0.f;
#pragma unroll
                for (int bj = 0; bj < 2; ++bj) { const f32x4 o0 = pre[m][bj][0] + acc[ai][bj][m][0], o1 = pre[m][bj][1] + acc[ai][bj][m][1];
                    if constexpr (OUT) { *(f32x4*)(out + off + bj * HALF) = o0; *(f32x4*)(out + off + bj * HALF + 4) = o1; }
                    if constexpr (HB) { *(u32x4*)(hb + off + bj * HALF) = pack8(o0, o1);
                        ss += ((o0[0] * o0[0] + o0[1] * o0[1]) + (o0[2] * o0[2] + o0[3] * o0[3])) + ((o1[0] * o1[0] + o1[1] * o1[1]) + (o1[2] * o1[2] + o1[3] * o1[3])); } }
                if constexpr (HB) { ss += __shfl_xor(ss, 16); ss += __shfl_xor(ss, 32); if (fq == 0) hp[(size_t)r * 64 + u.pn * 4 + wc] = ss; } }
            asm volatile("" ::: "memory");
        }
    }
};
template <class...> using pg8_void_t = void;
template <class E, class = void> struct pre_of { static constexpr bool has = false; };
template <class E> struct pre_of<E, pg8_void_t<typename E::Pre>> { static constexpr bool has = true; typename E::Pre p; };
template <class Epi, class Sched, bool ALIGN_EPI = false, bool SP2 = false>
__device__ __forceinline__ void gemm_phase(PG8_LAS unsigned char* lds, const Gemm g, const Sched& S, const Epi& E) {
    const int tid = threadIdx.x, wid = __builtin_amdgcn_readfirstlane(tid >> 6), lane = tid & 63, wr = wid >> 2, wc = wid & 3, fr = lane & 15, fq = lane >> 4;
    constexpr int T1 = Epi::T_I8;
    const int K = g.K, nt = K / BK, KA = T1 > 0 ? g.KA : g.K;
    unsigned voffA[2], voffB[2];
#pragma unroll
    for (int i = 0; i < 2; ++i) { int R, C; stage_rc(tid * 16 + i * 8192, R, C); const int Rb = Epi::PERM ? ((R & ~31) + perm32(R & 31)) : R;
        voffA[i] = (unsigned)(R * KA + C) * 2u; voffB[i] = (unsigned)(Rb * K + C) * 2u; }
    const size_t kstep = (size_t)(BK * 2);
    const size_t hstep = (size_t)HALF * K * 2, hstepA = (size_t)HALF * KA * 2;
    const size_t tstep = 2 * hstep, tstepA = 2 * hstepA;
    const unsigned ldsw = (unsigned)wid * 1024u;
    const int aoff = lds_byte(wr * 64 + fr, fq * 8), boff = lds_byte(wc * 32 + fr, fq * 8);
#define PG8_SA(b, h) (((b) * 2 + (h)) * HTB)
#define PG8_SB(b, h) ((4 + (b) * 2 + (h)) * HTB)
#define PG8_STAGE(bufoff, gbase, voff) do { _Pragma("unroll") for (int _i = 0; _i < 2; ++_i) { const char* _gb = (const char*)(gbase); asm volatile("" : "+s"(_gb));     \
        __builtin_amdgcn_global_load_lds((const unsigned*)(_gb + (voff)[_i]), (PG8_LAS unsigned*)(lds + (bufoff) + ldsw + _i * 8192), 16, 0, 0); } } while (0)
#define PG8_LDA(dst, b, h) do { _Pragma("unroll") for (int m = 0; m < 4; ++m) _Pragma("unroll") for (int k = 0; k < 2; ++k) dst[m][k] = *(const PG8_LAS bf16x8*)(lds + PG8_SA(b, h) + aoff + m * 2048 + k * 1024); } while (0)
#define PG8_LDB(dst, b, h) do { _Pragma("unroll") for (int n = 0; n < 2; ++n) _Pragma("unroll") for (int k = 0; k < 2; ++k) dst[n][k] = *(const PG8_LAS bf16x8*)(lds + PG8_SB(b, h) + boff + n * 2048 + k * 1024); } while (0)
#define PG8_MMA(I8X, ai, bj, At, Bt) do { __builtin_amdgcn_s_setprio(1); _Pragma("unroll") for (int m = 0; m < 4; ++m) _Pragma("unroll") for (int n = 0; n < 2; ++n) _Pragma("unroll") for (int k = 0; k < 2; ++k) \
        acc[ai][bj][m][n] = pg8_mma_x<I8X>(Bt[n][k], At[m][k], acc[ai][bj][m][n]); __builtin_amdgcn_s_setprio(0); } while (0)
#define PG8_WAIT_V(n) asm volatile("s_waitcnt vmcnt(" #n ")" ::: "memory")
#define PG8_WAIT_L(n) asm volatile("s_waitcnt lgkmcnt(" #n ")" ::: "memory")
#define PG8_BAR __builtin_amdgcn_s_barrier()
#define PG8_SCHED __builtin_amdgcn_sched_barrier(0)
    Unit cur, nxt; int ui = 0;
    if (!S.next(0, cur)) return;
    typedef typename Epi::acc_t acc_t;
    acc_t acc[2][2][4][2];
#pragma unroll
    for (int a = 0; a < 2; ++a)
#pragma unroll
        for (int b = 0; b < 2; ++b)
#pragma unroll
            for (int m = 0; m < 4; ++m)
#pragma unroll
                for (int n = 0; n < 2; ++n) acc[a][b][m][n] = pg8_zero((acc_t*)nullptr);
    bf16x8 At[4][2], B0[2][2], B1[2][2];
    const char* cA = (const char*)g.A + (size_t)cur.pm * tstepA; const char* cB = (const char*)g.Bt + (size_t)cur.pn * tstep;
    S.a_ready(cur);
    pre_of<Epi> pre; if constexpr (pre_of<Epi>::has) E.pre(pre.p, cur, wr, wc, fr, fq);
    static_assert(SP2, "only the two-super-phase K-loop is kept");
    PG8_STAGE(PG8_SB(0, 0), cB, voffB); PG8_STAGE(PG8_SB(0, 1), cB + hstep, voffB); PG8_STAGE(PG8_SA(0, 0), cA, voffA); PG8_STAGE(PG8_SA(0, 1), cA + hstepA, voffA);
    if (wr == 1) PG8_BAR;
    PG8_WAIT_V(2); PG8_BAR;
    PG8_STAGE(PG8_SB(1, 0), cB + kstep, voffB); PG8_STAGE(PG8_SA(1, 0), cA + kstep, voffA);
    PG8_WAIT_V(4); PG8_BAR;
    for (;;) {
        const bool has_next = S.next(ui + 1, nxt);
        const char* nA = has_next ? (const char*)g.A + (size_t)nxt.pm * tstepA : cA; const char* nB = has_next ? (const char*)g.Bt + (size_t)nxt.pn * tstep : cB;
#define PG8_KBODY(I8X) do { \
            PG8_LDB(B0, 0, 0); PG8_LDB(B1, 0, 1); PG8_SCHED; PG8_LDA(At, 0, 0); PG8_STAGE(PG8_SB(1, 1), b1 + hstep, voffB); PG8_STAGE(PG8_SA(1, 1), a1 + hstepA, voffA); \
            PG8_WAIT_V(8); PG8_WAIT_L(0); PG8_BAR; PG8_MMA(I8X, 0, 0, At, B0); PG8_MMA(I8X, 0, 1, At, B1); PG8_BAR; PG8_SCHED; \
            PG8_LDA(At, 0, 1); PG8_STAGE(PG8_SB(0, 0), b2, voffB); PG8_STAGE(PG8_SA(0, 0), a2, voffA); \
            PG8_WAIT_V(6); PG8_WAIT_L(0); PG8_BAR; PG8_MMA(I8X, 1, 0, At, B0); PG8_MMA(I8X, 1, 1, At, B1); PG8_BAR; PG8_SCHED; \
            PG8_LDB(B0, 1, 0); PG8_LDB(B1, 1, 1); PG8_SCHED; PG8_LDA(At, 1, 0); PG8_STAGE(PG8_SB(0, 1), b2 + hstep, voffB); PG8_STAGE(PG8_SA(0, 1), a2 + hstepA, voffA); \
            PG8_WAIT_V(8); PG8_WAIT_L(0); PG8_BAR; PG8_MMA(I8X, 0, 0, At, B0); PG8_MMA(I8X, 0, 1, At, B1); PG8_BAR; PG8_SCHED; \
            PG8_LDA(At, 1, 1); PG8_STAGE(PG8_SB(1, 0), b3, voffB); PG8_STAGE(PG8_SA(1, 0), a3, voffA); \
            PG8_WAIT_V(6); PG8_WAIT_L(0); PG8_BAR; PG8_MMA(I8X, 1, 0, At, B0); PG8_MMA(I8X, 1, 1, At, B1); PG8_BAR; PG8_SCHED; } while (0)
        if constexpr (T1 > 0) {
            const char* cA2 = cA + ((const char*)g.A2 - (const char*)g.A);
            for (int t = 0; t < T1; t += 2) {
                asm volatile("" : "+v"(voffA[0]), "+v"(voffA[1]), "+v"(voffB[0]), "+v"(voffB[1]));
                const char* a1 = cA + (size_t)(t + 1) * kstep; const char* b1 = cB + (size_t)(t + 1) * kstep;
                const char* a2 = (t == T1 - 2 ? cA2 : cA) + (size_t)(t + 2) * kstep; const char* b2 = cB + (size_t)(t + 2) * kstep;
                const char* a3 = a2 + kstep; const char* b3 = b2 + kstep;
                PG8_KBODY(true);
            }
            if constexpr (pre_of<Epi>::has) E.mid(acc, pre.p); else E.mid(acc, cur, wr, wc, fr, fq);
            for (int t = T1; t < nt; t += 2) {
                const bool last = (t == nt - 2);
                asm volatile("" : "+v"(voffA[0]), "+v"(voffA[1]), "+v"(voffB[0]), "+v"(voffB[1]));
                const char* a1 = cA2 + (size_t)(t + 1) * kstep; const char* b1 = cB + (size_t)(t + 1) * kstep;
                const char* a2 = last ? nA : cA2 + (size_t)(t + 2) * kstep; const char* b2 = last ? nB : cB + (size_t)(t + 2) * kstep;
                const char* a3 = a2 + kstep; const char* b3 = b2 + kstep;
                if (last && has_next) S.a_ready(nxt);
                PG8_KBODY(false);
            }
        } else {
        for (int t = 0; t < nt; t += 2) {
            if constexpr (Epi::MID_T >= 0) { if (t == Epi::MID_T) E.mid(acc, cur, wr, wc, fr, fq); }
            const bool last = (t == nt - 2);
            asm volatile("" : "+v"(voffA[0]), "+v"(voffA[1]), "+v"(voffB[0]), "+v"(voffB[1]));
            const char* a1 = cA + (size_t)(t + 1) * kstep; const char* b1 = cB + (size_t)(t + 1) * kstep;
            const char* a2 = last ? nA : cA + (size_t)(t + 2) * kstep; const char* b2 = last ? nB : cB + (size_t)(t + 2) * kstep;
            const char* a3 = a2 + kstep; const char* b3 = b2 + kstep;
            if (last && has_next) S.a_ready(nxt);
            PG8_KBODY(false);
        }
        }
        if constexpr (ALIGN_EPI) { if (wr == 0) PG8_BAR; }
        if constexpr (!Epi::AFTER_DRAIN) { if constexpr (pre_of<Epi>::has) E(acc, cur, wr, wc, fr, fq, pre.p); else E(acc, cur, wr, wc, fr, fq); S.done(cur); }
        if (!has_next) break;
#pragma unroll
        for (int a = 0; a < 2; ++a)
#pragma unroll
            for (int b = 0; b < 2; ++b)
#pragma unroll
                for (int m = 0; m < 4; ++m)
#pragma unroll
                    for (int n = 0; n < 2; ++n) acc[a][b][m][n] = pg8_zero((acc_t*)nullptr);
        cur = nxt; cA = nA; cB = nB; ++ui;
        if constexpr (pre_of<Epi>::has) E.pre(pre.p, cur, wr, wc, fr, fq);
        if constexpr (ALIGN_EPI) { if (wr == 1) PG8_BAR; }
    }
    PG8_WAIT_V(0);
    if constexpr (!ALIGN_EPI) { if (wr == 0) PG8_BAR; }
    PG8_BAR;
    if constexpr (Epi::AFTER_DRAIN) { E.fused(acc, cur, wr, wc, fr, fq, lds, wid, lane); S.done(cur); }
#undef PG8_SA
#undef PG8_SB
#undef PG8_STAGE
#undef PG8_LDA
#undef PG8_LDB
#undef PG8_MMA
#undef PG8_KBODY
#undef PG8_WAIT_V
#undef PG8_WAIT_L
#undef PG8_BAR
#undef PG8_SCHED
}
}
#define GAS __attribute__((address_space(1)))
#define LAS __attribute__((address_space(3)))
typedef unsigned short bf16;
typedef unsigned v4u __attribute__((ext_vector_type(4)));
typedef float f32x4 __attribute__((ext_vector_type(4)));
typedef short bf16x8 __attribute__((ext_vector_type(8)));
typedef GAS unsigned gu32;
typedef GAS unsigned long long gu64;
#define RLX_AGENT __ATOMIC_RELAXED, __HIP_MEMORY_SCOPE_AGENT
#define LDS_WAIT() asm volatile("s_waitcnt lgkmcnt(0)" ::: "memory")
#define VM_WAIT() asm volatile("s_waitcnt vmcnt(0)" ::: "memory")
__device__ __forceinline__ unsigned long long rt() { return __builtin_amdgcn_s_memrealtime(); }
__device__ __forceinline__ unsigned f2bf(float f) { unsigned u = __builtin_bit_cast(unsigned, f); return (u + 0x7fffu + ((u >> 16) & 1u)) >> 16; }
__device__ __forceinline__ unsigned pk2(float lo, float hi) { return f2bf(lo) | (f2bf(hi) << 16); }

#define XB_TMO      128
#define XB_XCNT(j)  (256  + 64 * (j))
#define XB_XSUB(j)  (1280 + 64 * (j))
#define XB_XGEN(j)  (2304 + 64 * (j))
#define XB_TOP      3328
#define XB_TOPGEN   3392
#define XCD_BAR_WORDS 3456
#define XB_SPIN_CAP (1u << 18)

__device__ __forceinline__ unsigned xb_ld(unsigned* p)              { return __hip_atomic_load(p, __ATOMIC_RELAXED, __HIP_MEMORY_SCOPE_AGENT); }
__device__ __forceinline__ unsigned xb_add(unsigned* p, unsigned v) { return __hip_atomic_fetch_add(p, v, __ATOMIC_RELAXED, __HIP_MEMORY_SCOPE_AGENT); }
__device__ __forceinline__ unsigned xb_xcc_id() { return (unsigned)__builtin_amdgcn_s_getreg((3 << 11) | 20) & 0xFu; }
#define XB_SPIN(cond, bar) do { unsigned _sp = 0; while (cond) { __builtin_amdgcn_s_sleep(1); \
    if ((++_sp & 255u) == 0u) { if (xb_ld(&(bar)[XB_TMO])) break; if (_sp > XB_SPIN_CAP) { atomicAdd(&(bar)[XB_TMO], 1u); break; } } } } while (0)

struct XcdBarrier {
    unsigned* bar; unsigned x;
    volatile LAS unsigned* st;
};

__device__ __forceinline__ XcdBarrier xcd_barrier_post(unsigned* bar, volatile LAS unsigned* st) {
    XcdBarrier b; b.bar = bar; b.x = xb_xcc_id(); b.st = st;
    if (threadIdx.x == 0) (void)xb_add(&bar[XB_XCNT(b.x)], 1u);
    return b;
}
__device__ __forceinline__ void xcd_barrier_complete(unsigned* bar, unsigned x, unsigned& nloc, unsigned& nx) {
    const unsigned G = gridDim.x * gridDim.y * gridDim.z;
    unsigned sum, cnt, mine, sp = 0u;
    for (;;) {
        sum = 0u; cnt = 0u; mine = 0u;
#pragma unroll
        for (unsigned j = 0; j < 16; ++j) { const unsigned c = xb_ld(&bar[XB_XCNT(j)]); sum += c; cnt += (c > 0u) ? 1u : 0u; mine = (j == x) ? c : mine; }
        if (sum == G) break;
        __builtin_amdgcn_s_sleep(1);
        if ((++sp & 255u) == 0u) { if (xb_ld(&bar[XB_TMO])) break; if (sp > XB_SPIN_CAP) { atomicAdd(&bar[XB_TMO], 1u); break; } }
    }
    nloc = mine > 0u ? mine : 1u; nx = cnt > 0u ? cnt : 1u;
}

__device__ __forceinline__ void xcd_barrier(const XcdBarrier& b) {
    asm volatile("s_waitcnt vmcnt(0)" ::: "memory");
    __syncthreads();
    if (threadIdx.x == 0) {
        unsigned* bar = b.bar;
        __builtin_amdgcn_s_waitcnt(0);
        unsigned nloc = b.st[0], nx = b.st[1];
        if (nloc == 0u) { xcd_barrier_complete(bar, b.x, nloc, nx); b.st[0] = nloc; b.st[1] = nx; }
        const unsigned old = xb_add(&bar[XB_XSUB(b.x)], 1u);
        const unsigned gen = old / nloc;
        if (old + 1u == (gen + 1u) * nloc) {
            __builtin_amdgcn_fence(__ATOMIC_RELEASE, "agent");
            asm volatile("s_waitcnt vmcnt(0)" ::: "memory");
            const unsigned og = xb_add(&bar[XB_TOP], 1u);
            const unsigned tg = og / nx;
            if (og + 1u == (tg + 1u) * nx) xb_add(&bar[XB_TOPGEN], 1u);
            else XB_SPIN(xb_ld(&bar[XB_TOPGEN]) == tg, bar);
            __builtin_amdgcn_fence(__ATOMIC_ACQUIRE, "agent");
            xb_add(&bar[XB_XGEN(b.x)], 1u);
            asm volatile("s_waitcnt vmcnt(0)" ::: "memory");
        } else {
            XB_SPIN(xb_ld(&bar[XB_XGEN(b.x)]) == gen, bar);
            __builtin_amdgcn_fence(__ATOMIC_ACQUIRE, "agent");
            asm volatile("s_waitcnt vmcnt(0)" ::: "memory");
        }
    }
    __syncthreads();
}
namespace fox {
constexpr int D = 128, QP = 6144, KP = 6144, OP = 3072;
constexpr float THR = 8.f; constexpr bool WSKIP = false;
constexpr int NW = 8, QBLK = 32, KVBLK = 64, QB = NW * QBLK;
constexpr int SHM_V = KVBLK * D * 2, SHM_K = KVBLK * D * 2;
constexpr int LDS_WS = 2 * SHM_V + 2 * SHM_K, WS_STRIDE = 768;
constexpr int LDS_BYTES = LDS_WS + NW * WS_STRIDE;

using bf16 = __hip_bfloat16;
#define FOX_LAS __attribute__((address_space(3)))
typedef short bf16x8 __attribute__((ext_vector_type(8)));
typedef short s16x4 __attribute__((ext_vector_type(4)));
typedef float f32x16 __attribute__((ext_vector_type(16)));
typedef float f32x4 __attribute__((ext_vector_type(4)));
typedef unsigned u32x4 __attribute__((ext_vector_type(4)));
template <class A, class Bt> struct same_t { static constexpr bool v = false; };
template <class A> struct same_t<A, A> { static constexpr bool v = true; };

#define KSWZ(row, colB) ((row) * 256 + ((colB) ^ (((row) & 7) << 4)))
#define SBAR() __builtin_amdgcn_sched_barrier(0)
__device__ __forceinline__ int v_st(int k, int c) { const int kk = (k & ~0xC) | ((k & 4) << 1) | ((k & 8) >> 1); return ((kk >> 3) * 4 + (c >> 5)) * 512 + ((kk & 7) * 32 + (c & 31)) * 2; }
__device__ __forceinline__ int v_rd_base(int lane) { return ((lane & 3) << 3) | (((lane >> 2) & 3) << 6) | (((lane >> 4) & 1) << 5) | (((lane >> 5) & 1) << 8); }
constexpr int v_rd_off(int d0, int ks, int half) { return d0 * 512 + ks * 4096 + half * 2048; }
__device__ __forceinline__ int crow(int r, int hi) { return (r & 3) + 8 * (r >> 2) + 4 * hi; }
typedef float f32x2a_t __attribute__((ext_vector_type(2))); typedef __bf16 bf16x2a_t __attribute__((ext_vector_type(2)));
__device__ __forceinline__ unsigned cvtpk(float lo, float hi) {
    const f32x2a_t v = {lo, hi}; const bf16x2a_t b = __builtin_convertvector(v, bf16x2a_t); return __builtin_bit_cast(unsigned, b);
}
__device__ __forceinline__ bf16x8 pack8(f32x4 a, f32x4 b) {
    u32x4 w = {cvtpk(a[0], a[1]), cvtpk(a[2], a[3]), cvtpk(b[0], b[1]), cvtpk(b[2], b[3])};
    return *reinterpret_cast<bf16x8*>(&w);
}
template <class T> __device__ __forceinline__ bf16x8 load8(const T* p) {
    if constexpr (same_t<T, float>::v) { return pack8(*(const f32x4*)p, *(const f32x4*)(p + 4)); }
    else { return *reinterpret_cast<const bf16x8*>(p); }
}
__device__ __forceinline__ void mask_tile(f32x16& p0, f32x16& p1, int dq, unsigned W) {
    const float NEG = -__builtin_inff();
#pragma unroll
    for (int r = 0; r < 16; ++r) {
        const int c = (r & 3) + 8 * (r >> 2);
        if ((unsigned)(dq - c) >= W) p0[r] = NEG;
        if ((unsigned)(dq - c - 32) >= W) p1[r] = NEG;
    }
}
__device__ __forceinline__ void partialSM(f32x16& p0, f32x16& p1, float& m_reg, float& mn, float& alpha) {
    float pmax = p0[0]; for (int r = 1; r < 16; ++r) pmax = fmaxf(pmax, p0[r]); for (int r = 0; r < 16; ++r) pmax = fmaxf(pmax, p1[r]);
    { auto rr = __builtin_amdgcn_permlane32_swap(__float_as_uint(pmax), __float_as_uint(pmax), false, false);
      pmax = fmaxf(__uint_as_float(rr[0]), __uint_as_float(rr[1])); }
    if (__builtin_expect(__all((pmax - m_reg) <= THR), 1)) { mn = m_reg; alpha = 1.f; }
    else { mn = fmaxf(m_reg, pmax); alpha = __builtin_amdgcn_exp2f(m_reg - mn); m_reg = mn; }
    for (int r = 0; r < 16; ++r) p0[r] = p0[r] - mn; for (int r = 0; r < 16; ++r) p1[r] = p1[r] - mn;
    for (int r = 0; r < 16; ++r) p0[r] = __builtin_amdgcn_exp2f(p0[r]);
}
__device__ __forceinline__ void finishSM(f32x16& p0, f32x16& p1, float alpha, float& l_reg, bf16x8& pa0, bf16x8& pa1, bf16x8& pa2, bf16x8& pa3) {
    for (int r = 0; r < 16; ++r) p1[r] = __builtin_amdgcn_exp2f(p1[r]);
    float ps = 0; for (int r = 0; r < 16; ++r) ps += p0[r]; for (int r = 0; r < 16; ++r) ps += p1[r];
    { auto rr = __builtin_amdgcn_permlane32_swap(__float_as_uint(ps), __float_as_uint(ps), false, false);
      ps = __uint_as_float(rr[0]) + __uint_as_float(rr[1]); }
    l_reg = l_reg * alpha + ps;
#define PK4(P, B_, OUT) do { unsigned a0 = cvtpk(P[B_+0], P[B_+1]), a1 = cvtpk(P[B_+2], P[B_+3]);                          \
        unsigned b0 = cvtpk(P[B_+4], P[B_+5]), b1 = cvtpk(P[B_+6], P[B_+7]);                                             \
        auto r0 = __builtin_amdgcn_permlane32_swap(a0, b0, false, false); auto r1 = __builtin_amdgcn_permlane32_swap(a1, b1, false, false); \
        u32x4 w = {r0[0], r1[0], r0[1], r1[1]}; OUT = *reinterpret_cast<bf16x8*>(&w); } while (0)
    PK4(p0, 0, pa0); PK4(p0, 8, pa1); PK4(p1, 0, pa2); PK4(p1, 8, pa3);
#undef PK4
}
template <int KB, bool SK>
__device__ __forceinline__ void qkt(f32x16& p0, f32x16& p1, const char* K_lds, const char* F_lds, int r32, int hi, const bf16x8* qr, bool act) {
    if (SK && !act) { const float NEG = -__builtin_inff();
#pragma unroll
        for (int r = 0; r < 16; ++r) { p0[r] = NEG; p1[r] = NEG; } return; }
    { const float* fl = (const float*)(F_lds + KB * 256) + 4 * hi;
#pragma unroll
      for (int g_ = 0; g_ < 4; ++g_) { const f32x4 a = *(const f32x4*)(fl + 8 * g_), b = *(const f32x4*)(fl + 32 + 8 * g_);
          p0[4 * g_] = a[0]; p0[4 * g_ + 1] = a[1]; p0[4 * g_ + 2] = a[2]; p0[4 * g_ + 3] = a[3]; p1[4 * g_] = b[0]; p1[4 * g_ + 1] = b[1]; p1[4 * g_ + 2] = b[2]; p1[4 * g_ + 3] = b[3]; } }
    const char* kb[4];
#pragma unroll
    for (int dd = 0; dd < 4; ++dd) kb[dd] = K_lds + KB * SHM_K + KSWZ(r32, (dd * 16 + hi * 8) * 2);
#pragma unroll
    for (int d0 = 0; d0 < 8; ++d0) { const char* a = kb[d0 & 3] + (d0 >> 2) * 128;
        bf16x8 b0 = *reinterpret_cast<const bf16x8*>(a);
        bf16x8 b1 = *reinterpret_cast<const bf16x8*>(a + 32 * 256);
        p0 = __builtin_amdgcn_mfma_f32_32x32x16_bf16(b0, qr[d0], p0, 0, 0, 0);
        p1 = __builtin_amdgcn_mfma_f32_32x32x16_bf16(b1, qr[d0], p1, 0, 0, 0); }
}
template <int VB, bool SK>
__device__ __forceinline__ void pv_tile(f32x16* o, int vb0, bf16x8 pa0, bf16x8 pa1, bf16x8 pa2, bf16x8 pa3, bool act) {
    if (SK && !act) return;
#define TRRD(dst, off) asm volatile("ds_read_b64_tr_b16 %0, %1 offset:%2" : "=&v"(dst) : "v"(vb0), "i"(off) : "memory")
#define PV_D0(d0) do { s16x4 l0, l1, l2, l3, h0, h1, h2, h3; constexpr int b_ = VB * SHM_V + v_rd_off(d0, 0, 0);     \
        TRRD(l0, b_); TRRD(h0, b_ + 2048); TRRD(l1, b_ + 4096); TRRD(h1, b_ + 6144); TRRD(l2, b_ + 8192); TRRD(h2, b_ + 10240); TRRD(l3, b_ + 12288); TRRD(h3, b_ + 14336); \
        asm volatile("s_waitcnt lgkmcnt(0)" ::: "memory"); SBAR();                 \
        o[d0] = __builtin_amdgcn_mfma_f32_32x32x16_bf16(pa0, (bf16x8){l0[0], l0[1], l0[2], l0[3], h0[0], h0[1], h0[2], h0[3]}, o[d0], 0, 0, 0);   \
        o[d0] = __builtin_amdgcn_mfma_f32_32x32x16_bf16(pa1, (bf16x8){l1[0], l1[1], l1[2], l1[3], h1[0], h1[1], h1[2], h1[3]}, o[d0], 0, 0, 0);   \
        o[d0] = __builtin_amdgcn_mfma_f32_32x32x16_bf16(pa2, (bf16x8){l2[0], l2[1], l2[2], l2[3], h2[0], h2[1], h2[2], h2[3]}, o[d0], 0, 0, 0);   \
        o[d0] = __builtin_amdgcn_mfma_f32_32x32x16_bf16(pa3, (bf16x8){l3[0], l3[1], l3[2], l3[3], h3[0], h3[1], h3[2], h3[3]}, o[d0], 0, 0, 0); } while (0)
    PV_D0(0); PV_D0(1); PV_D0(2); PV_D0(3);
#undef PV_D0
#undef TRRD
}

template <class TIn, class TOut> struct BlockRef { const TIn* Q; const TIn* K; const TIn* V; TOut* O; const float* F; int P0, NT; float LH; };
__device__ __forceinline__ int fox_nt(const float* Fn, int P0, float lim) {
    int lane = threadIdx.x & 63; asm volatile("" : "+v"(lane));
    const int j_hi = P0 / KVBLK + QB / KVBLK;
    const float f0 = Fn[P0]; const bool in = lane < j_hi; const float v = in ? Fn[KVBLK * lane + KVBLK - 1] : 0.f;
    const unsigned long long need = __ballot(in && (f0 - v <= lim));
    const int j_stop = need ? (int)__builtin_ctzll(need) : 0;
    return j_hi - j_stop;
}
template <class TIn> struct Seam {
    bf16x8 qr[8];
    bf16x8 st_v0, st_v1, st_k0, st_k1; f32x4 sf0, sf1, sf2, sf3;
    float st_f;
    f32x4 tq[16];
};
__device__ __forceinline__ int swa_jlo(int P0, int W) { const int lowk = P0 - W + 1; return lowk > 0 ? lowk / KVBLK : 0; }
#define ROW(p, k0, rr) ((p) + (size_t)((k0) + (rr)) * KP + sc)
#define VMW() asm volatile("s_waitcnt vmcnt(0)" ::: "memory")
#define VMWN(n) asm volatile("s_waitcnt vmcnt(%0)" :: "i"(n) : "memory")
#define SLOAD_H(Kp, Vp, Fp, k0) do { S.st_v0 = load8<TIn>(ROW(Vp, k0, sr)); S.st_v1 = load8<TIn>(ROW(Vp, k0, 32 + sr));              \
                         S.st_k0 = load8<TIn>(ROW(Kp, k0, sr)); S.st_k1 = load8<TIn>(ROW(Kp, k0, 32 + sr)); S.st_f = (Fp)[(k0) + lane]; } while (0)
#define SWRITE_HK(bf) do { *(bf16x8*)(K_lds + (bf) * SHM_K + kws) = S.st_k0; *(bf16x8*)(K_lds + (bf) * SHM_K + kws + 32 * 256) = S.st_k1; ((float*)(F_lds + (bf) * 256))[lane] = S.st_f; } while (0)
#define SWRITE_HV(bf) do { *(bf16x8*)(V_lds + (bf) * SHM_V + vst0) = S.st_v0; *(bf16x8*)(V_lds + (bf) * SHM_V + vst1) = S.st_v1; } while (0)
#define SWRITE_H(bf) do { SWRITE_HV(bf); SWRITE_HK(bf); } while (0)
#define SLOAD_F(p, k0) do { S.sf0 = *(const f32x4*)ROW(p, k0, sr); S.sf1 = *(const f32x4*)(ROW(p, k0, sr) + 4);                \
                            S.sf2 = *(const f32x4*)ROW(p, k0, 32 + sr); S.sf3 = *(const f32x4*)(ROW(p, k0, 32 + sr) + 4); } while (0)
#define SWRITE_KF(bf) do { *(bf16x8*)(K_lds + (bf) * SHM_K + kws) = pack8(S.sf0, S.sf1); *(bf16x8*)(K_lds + (bf) * SHM_K + kws + 32 * 256) = pack8(S.sf2, S.sf3); } while (0)
#define SWRITE_VF(bf) do { *(bf16x8*)(V_lds + (bf) * SHM_V + vst0) = pack8(S.sf0, S.sf1); *(bf16x8*)(V_lds + (bf) * SHM_V + vst1) = pack8(S.sf2, S.sf3); } while (0)
template <class TIn, class TOut>
__device__ __forceinline__ void causal_swa_prime(const BlockRef<TIn, TOut>& cur, int W, char* lds, Seam<TIn>& S) {
    constexpr bool F32 = same_t<TIn, float>::v;
    const int tid = threadIdx.x, wid = __builtin_amdgcn_readfirstlane(tid >> 6), lane = tid & 63, r32 = lane & 31, hi = lane >> 5;
    const int sr = tid >> 4, sc = (tid & 15) * 8, kws = KSWZ(sr, sc * 2); char* K_lds = lds + 2 * SHM_V; char* F_lds = lds + LDS_WS + wid * WS_STRIDE + 256;
    const int kb0 = ((cur.P0 + QB - 1) / KVBLK) * KVBLK;
    for (int d0 = 0; d0 < 8; ++d0) S.qr[d0] = load8<TIn>(cur.Q + (size_t)(wid * QBLK + r32) * QP + d0 * 16 + hi * 8);
    if constexpr (F32) { SLOAD_F((const float*)cur.K, kb0); VMW(); SWRITE_KF(0); SBAR(); SLOAD_F((const float*)cur.V, kb0); }
    else { SLOAD_H(cur.K, cur.V, cur.F, kb0); VMW(); SWRITE_HK(0); }
    __syncthreads();
}
template <class TIn, class TOut>
__device__ __forceinline__ void causal_swa_block(const BlockRef<TIn, TOut>& cur, const BlockRef<TIn, TOut>& nxt, int skv, int W, char* lds, Seam<TIn>& S) {
    constexpr bool F32 = same_t<TIn, float>::v;
    const int tid = threadIdx.x, wid = __builtin_amdgcn_readfirstlane(tid >> 6), lane = tid & 63, r32 = lane & 31, hi = lane >> 5;
    int j_hi = (cur.P0 + QB - 1) / KVBLK + 1; if (j_hi > skv / KVBLK) j_hi = skv / KVBLK;
    int NT = cur.NT;
    const int kbn = ((nxt.P0 + QB - 1) / KVBLK) * KVBLK;
    const int qlo = cur.P0 + wid * QBLK, qm = qlo + r32 - 4 * hi;
    char* V_lds = lds; char* K_lds = lds + 2 * SHM_V;
    float* ws = (float*)(lds + LDS_WS + wid * WS_STRIDE); float* li_l = ws, * al_l = ws + 32; char* F_lds = (char*)(ws + 64);
    float m_reg = -1e30f, l_reg = 0; f32x16 o[4] = {};
    const int sr = tid >> 4, sc = (tid & 15) * 8, vst0 = v_st(sr, sc), vst1 = v_st(32 + sr, sc), kws = KSWZ(sr, sc * 2);
    const int vb0 = (int)(uintptr_t)V_lds + v_rd_base(lane);
    const TIn* Kh = cur.K; const TIn* Vh = cur.V; const float* Fh = cur.F;
#define RESC(a) do { if (__any((a) < 1.f)) { if (hi == 0) al_l[r32] = (a); asm volatile("s_waitcnt lgkmcnt(0)" ::: "memory");              \
                     for (int d_ = 0; d_ < 4; ++d_) for (int r = 0; r < 16; ++r) o[d_][r] *= al_l[crow(r, hi)]; } } while (0)
#define KBASE(t) ((j_hi - 1 - (t)) * KVBLK)
#define ACT(t) (KBASE(t) <= qlo + QBLK - 1 && KBASE(t) + KVBLK - 1 >= qlo - W + 1)
#define MASKT(P0_, P1_, t) do { const int kb_ = KBASE(t); if ((!SK || ACT(t)) && (kb_ + KVBLK - 1 > qlo || kb_ <= qlo + QBLK - 1 - W)) mask_tile(P0_, P1_, qm - kb_, (unsigned)W); } while (0)
    constexpr int NQL = F32 ? 16 : 8;
    constexpr bool SK = WSKIP && !F32;
#define SEAM_K0() do { VMWN(NQL); if constexpr (F32) { SWRITE_KF(0); SBAR(); SLOAD_F((const float*)nxt.V, kbn); } else { SWRITE_HK(0); } SBAR(); } while (0)
    f32x16 pA0, pA1, pB0, pB1; float mnA, mnB, alA, alB; bf16x8 pa0, pa1, pa2, pa3;
    if constexpr (F32) { VMW(); SWRITE_VF(0); SBAR(); } else { SWRITE_HV(0); SBAR(); }
    if (NT > 1) { if constexpr (F32) SLOAD_F((const float*)Kh, KBASE(1)); else SLOAD_H(Kh, Vh, Fh, KBASE(1)); }
    SBAR(); qkt<0, SK>(pA0, pA1, K_lds, F_lds, r32, hi, S.qr, ACT(0));
    if constexpr (F32) { if (NT > 1) { VMW(); SWRITE_KF(1); SBAR(); SLOAD_F((const float*)Vh, KBASE(1)); } }
    MASKT(pA0, pA1, 0); partialSM(pA0, pA1, m_reg, mnA, alA);
    if (NT > 1) { VMW(); if constexpr (F32) { SWRITE_VF(1); SBAR(); if (NT > 2) SLOAD_F((const float*)Kh, KBASE(2)); } else SWRITE_H(1); }
    __syncthreads();
#define HALF_STEP(PX0, PX1, mnX, alX, PY0, PY1, alY, t, KB, VB, SB) do {                                                      \
        SBAR(); qkt<KB, SK>(PX0, PX1, K_lds, F_lds, r32, hi, S.qr, ACT(t));                                             \
        finishSM(PY0, PY1, alY, l_reg, pa0, pa1, pa2, pa3); SBAR();                                                           \
        if ((t) + 1 < NT) { if constexpr (F32) { VMW(); SWRITE_KF(SB); SBAR(); SLOAD_F((const float*)Vh, KBASE((t) + 1)); }  \
                            else { SLOAD_H(Kh, Vh, Fh, KBASE((t) + 1)); } SBAR(); }                                               \
        pv_tile<VB, SK>(o, vb0, pa0, pa1, pa2, pa3, ACT((t) - 1)); MASKT(PX0, PX1, (t)); partialSM(PX0, PX1, m_reg, mnX, alX);                                        \
        __syncthreads();                                                                                                      \
        if ((t) + 1 < NT) { VMW(); if constexpr (F32) { SWRITE_VF(SB); SBAR(); if ((t) + 2 < NT) SLOAD_F((const float*)Kh, KBASE((t) + 2)); } \
                            else { SWRITE_H(SB); } }                                                                          \
        RESC(alX); __syncthreads(); } while (0)
    for (int t = 1; t + 1 < NT; t += 2) {
        if (t == 5) {
            int lv = 0;
            const float f0_ = Fh[cur.P0];
#pragma unroll
            for (int k_ = 0; k_ < 6; ++k_) lv += __all(m_reg - f0_ >= (float)(2 * k_ - 6)) ? 1 : 0;
            { int ln_ = threadIdx.x & 63; asm volatile("" : "+v"(ln_)); if (ln_ == 0) *(int*)al_l = lv; }
            __syncthreads();
#pragma unroll
            for (int w_ = 0; w_ < NW; ++w_) { const int o_ = __builtin_amdgcn_readfirstlane(*(const int*)(lds + LDS_WS + w_ * WS_STRIDE + 128)); lv = o_ < lv ? o_ : lv; }
            __syncthreads();
            if (lv > 0) { const int ntd = fox_nt(Fh, cur.P0, cur.LH - (float)(2 * lv - 8));
                const int ntm = ntd > t + 2 ? ntd : t + 2;
                NT = ntm < NT ? ntm : NT; }
        }
        HALF_STEP(pB0, pB1, mnB, alB, pA0, pA1, alA, t, 1, 0, 0);
        HALF_STEP(pA0, pA1, mnA, alA, pB0, pB1, alB, t + 1, 0, 1, 1);
    }
    int r32t = threadIdx.x & 31, hit = (threadIdx.x >> 5) & 1; asm volatile("" : "+v"(r32t), "+v"(hit));
    const bool even = (NT & 1) == 0;
    if (even) { SBAR(); qkt<1, SK>(pB0, pB1, K_lds, F_lds, r32, hi, S.qr, ACT(NT - 1)); SBAR(); }
#define QROW(e) (nxt.Q + (size_t)(wid * QBLK + r32) * QP + ((e) >> 1) * 16 + hi * 8 + ((e) & 1) * 4)
    if constexpr (F32) { SLOAD_F((const float*)nxt.K, kbn); SBAR();
#pragma unroll
        for (int e = 0; e < 8; ++e) S.tq[e] = *(const f32x4*)QROW(e); }
    else { SLOAD_H(nxt.K, nxt.V, nxt.F, kbn); SBAR();
#pragma unroll
        for (int d0 = 0; d0 < 8; ++d0) S.qr[d0] = load8<TIn>(nxt.Q + (size_t)(wid * QBLK + r32t) * QP + d0 * 16 + hit * 8); }
    SBAR();
    finishSM(pA0, pA1, alA, l_reg, pa0, pa1, pa2, pa3); SBAR();
    if constexpr (F32) {
#pragma unroll
        for (int e = 8; e < 16; ++e) S.tq[e] = *(const f32x4*)QROW(e); SBAR(); }
#undef QROW
    pv_tile<0, SK>(o, vb0, pa0, pa1, pa2, pa3, ACT(even ? NT - 2 : NT - 1));
    if (even) { MASKT(pB0, pB1, NT - 1); partialSM(pB0, pB1, m_reg, mnB, alB); __syncthreads(); RESC(alB);
        finishSM(pB0, pB1, alB, l_reg, pa0, pa1, pa2, pa3); SBAR(); pv_tile<1, SK>(o, vb0, pa0, pa1, pa2, pa3, ACT(NT - 1)); }
    SBAR(); SEAM_K0();
    if (hit == 0) li_l[r32t] = l_reg; asm volatile("s_waitcnt lgkmcnt(0)" ::: "memory");
    float rli[16];
#pragma unroll
    for (int r = 0; r < 16; ++r) rli[r] = __builtin_amdgcn_rcpf(li_l[crow(r, hit)]);
    TOut* Ow = cur.O + (size_t)(wid * QBLK) * OP;
#pragma unroll
    for (int r = 0; r < 16; ++r) { const int orow = crow(r, hit);
#pragma unroll
        for (int d0 = 0; d0 < 4; ++d0) { const float v = o[d0][r] * rli[r];
            if constexpr (same_t<TOut, float>::v) { Ow[(size_t)orow * OP + d0 * 32 + r32] = v; }
            else { const float vn = __shfl_xor(v, 1);
                   if ((r32t & 1) == 0) *(unsigned*)(Ow + (size_t)orow * OP + d0 * 32 + r32t) = cvtpk(v, vn); } } }
    if constexpr (F32) {
#pragma unroll
        for (int d0 = 0; d0 < 8; ++d0) S.qr[d0] = pack8(S.tq[2 * d0], S.tq[2 * d0 + 1]); }
    __syncthreads();
#undef RESC
#undef KBASE
#undef ACT
#undef MASKT
#undef SEAM_K0
#undef HALF_STEP
}
#undef ROW
#undef VMW
#undef VMWN
#undef SLOAD_H
#undef SWRITE_HK
#undef SWRITE_HV
#undef SWRITE_H
#undef SLOAD_F
#undef SWRITE_KF
#undef SWRITE_VF

}
constexpr int NWAVES = 8;
constexpr int BATCH = 4, SEQ = 4096, DM = 4096, M = BATCH * SEQ;
constexpr int NH = 16, HD = 128, FOXW = 2048, NQKV = 6144, S5W = 1024, NGATE = 8192, N1 = NQKV + S5W + NGATE;
constexpr int INCOLS = 15376, DFF = 11008, NGU = 2 * DFF, N1B = NQKV + S5W;
constexpr int S5G = 64, S5P = 64, S5C = 16, S5L = 32, S5K = S5C * S5L, S5NCH = SEQ / S5L;
constexpr int KQ = 2816, T_GU8 = KQ / 128, PAGU = KQ + 2 * (DM - KQ);
constexpr float RMS_EPS = 1e-6f;
constexpr float LOG2E = 1.4426950408889634f;
constexpr float QSCALE = 0.08838834764831845f * LOG2E;
enum { I_X = 0, I_GMIX, I_WIN, I_BF, I_BG, I_QN, I_KN, I_LRE, I_LIM, I_LSTEP, I_BRE, I_BIM, I_CRE, I_CIM, I_SD, I_WGLU, I_BGLU, I_WPF, I_WPS, I_WOUT, I_GFFN, I_WGU, I_WDN, N_IN };

constexpr size_t MiB = 1u << 20;
constexpr size_t WS_CTL = 0, CTL_ZERO_BYTES = 1 * MiB;
constexpr size_t WS_RS1 = 1 * MiB, WS_RS2 = WS_RS1 + 65536, WS_RSX = WS_RS1 + 131072, WS_SW = WS_RS1 + 196608, WS_SWO = WS_RS1 + 262144, WS_SAM = WS_RS1 + 327680;
constexpr size_t WS_SAH = WS_RS1 + 393216, WS_SBGU = WS_RS1 + 458752;
constexpr size_t WS_LS = 2 * MiB, WS_FK = 3 * MiB;
constexpr size_t WS_HP = 4 * MiB;
constexpr size_t WS_WF = 8 * MiB;
constexpr size_t WS_S5T = 9 * MiB;
constexpr size_t WS_W1 = 16 * MiB, WS_WGLU = 136 * MiB, WS_WPF = 138 * MiB, WS_WPS = 154 * MiB, WS_WO = 162 * MiB, WS_WGU = 194 * MiB, WS_WD = 366 * MiB;
constexpr size_t WS_RA = 452 * MiB;
constexpr size_t WS_RB = 580 * MiB;
constexpr size_t WS_WG8 = 16 * MiB;
constexpr size_t WS_QKV = 708 * MiB, WS_S5IN = 900 * MiB, WS_GATES = 932 * MiB, WS_ACT = 708 * MiB;
constexpr size_t WS_ATTN = 1188 * MiB, WS_G = 1284 * MiB;
constexpr int ASP = FOXW + S5W;
constexpr size_t WS_KT = 1316 * MiB, WS_ET = 1317 * MiB, WS_OM = 1325 * MiB, WS_LBL = 1333 * MiB, WS_END = 1334 * MiB;
static_assert(KQ % 256 == 0 && KQ >= 256 && KQ < DM && (size_t)M * DM * 2 <= WS_QKV - WS_RB, "mixed gate/up operand");
static_assert(WS_WG8 + (size_t)N1 * DM <= WS_WGLU && WS_WGU + (size_t)NGU * PAGU <= WS_WD && WS_WD + (size_t)DM * DFF * 2 <= WS_RA, "weights map");
static_assert(WS_ACT + (size_t)M * DFF * 2 <= WS_ATTN && WS_GATES + (size_t)M * NGATE * 2 <= WS_ATTN, "activation map");
constexpr int CW_TMO = 0, CW_ATTNQ = 1024, CW_BAR = 4096, CW_CMAX = 131072, CW_CMAXO = CW_CMAX + 16384, CW_CMAXGU = CW_CMAXO + 4096;

static_assert(N1 <= 16384 && (CW_CMAXGU + NGU) * 4 <= (int)CTL_ZERO_BYTES && WS_SBGU + (size_t)NGU * 4 <= WS_LS, "control words");
constexpr int RING_OFF = 0, RING_BYTES = 131072;
constexpr int LDSCTL_OFF = RING_BYTES, MISC_OFF = LDSCTL_OFF + 320;
constexpr int QKP_OFF = LDSCTL_OFF + 1024;
constexpr int LDS_BYTES = 147456;
static_assert(QKP_OFF + 8192 <= LDS_BYTES, "LDS map");

__device__ __forceinline__ float wave_sum(float v) {
#pragma unroll
    for (int o = 1; o < 64; o <<= 1) v += __shfl_xor(v, o);
    return v;
}
__device__ __forceinline__ float wave_max(float v) {
#pragma unroll
    for (int o = 1; o < 64; o <<= 1) v = fmaxf(v, __shfl_xor(v, o));
    return v;
}
__device__ __forceinline__ float gelu_tanh(float x) {
    const float u = x * x * (-2.0f * 0.7978845608028654f * 0.044715f * LOG2E) + (-2.0f * 0.7978845608028654f * LOG2E);
    return x * __builtin_amdgcn_rcpf(1.0f + __builtin_amdgcn_exp2f(u * x));
}
__device__ __forceinline__ float log_sigmoid_f(float v) { return fminf(v, 0.f) - log1pf(__expf(-fabsf(v))); }

__device__ __forceinline__ void p0_tr_item(const float* W, size_t ldw, int src_col, const float* kscale, bf16* WT, int K, int dst_row, int k0, LAS unsigned char* scr, int lane, int kdst = 0, const float* cmax = nullptr) {
    const int c = lane & 15, r = lane >> 4;
    const GAS float* src = (const GAS float*)W + (size_t)(k0 + 16 * r) * ldw + src_col + 4 * c;
    f32x4 v[16];
#pragma unroll
    for (int i = 0; i < 16; ++i) v[i] = __builtin_nontemporal_load((const GAS f32x4*)(src + (size_t)i * ldw));
    if (kscale) {
#pragma unroll
        for (int q = 0; q < 4; ++q) { const f32x4 sc = *(const GAS f32x4*)((const GAS float*)kscale + k0 + 16 * r + 4 * q);
            v[4 * q] = v[4 * q] * sc.x; v[4 * q + 1] = v[4 * q + 1] * sc.y; v[4 * q + 2] = v[4 * q + 2] * sc.z; v[4 * q + 3] = v[4 * q + 3] * sc.w; } }
    if (cmax) {
        f32x4 cm = *(const GAS f32x4*)((const GAS float*)cmax + dst_row + 4 * c);
#pragma unroll
        for (int j = 0; j < 4; ++j) cm[j] = 127.0f / (cm[j] > 0.f ? cm[j] : 1.0f);
#pragma unroll
        for (int i = 0; i < 16; ++i) v[i] = v[i] * cm; }
#pragma unroll
    for (int j = 0; j < 4; ++j)
#pragma unroll
        for (int h = 0; h < 2; ++h) { v4u o;
            o.x = pg8::cvt_pk_bf16(v[8 * h][j], v[8 * h + 1][j]); o.y = pg8::cvt_pk_bf16(v[8 * h + 2][j], v[8 * h + 3][j]);
            o.z = pg8::cvt_pk_bf16(v[8 * h + 4][j], v[8 * h + 5][j]); o.w = pg8::cvt_pk_bf16(v[8 * h + 6][j], v[8 * h + 7][j]);
            *(LAS v4u*)(scr + (4 * c + j) * 144 + (2 * r + h) * 16) = o; }
    LDS_WAIT(); asm volatile("" ::: "memory");
#pragma unroll
    for (int i = 0; i < 8; ++i) { const int n = (lane >> 3) + 8 * i; const v4u o = *(const LAS v4u*)(scr + n * 144 + (lane & 7) * 16);
        *(GAS v4u*)(WT + (size_t)(dst_row + n) * K + kdst + k0 + 8 * (lane & 7)) = o; }
    LDS_WAIT(); asm volatile("" ::: "memory");
}


__device__ __forceinline__ unsigned q8pack4(float a, float b, float c, float d) {
    return ((unsigned)(int)__builtin_rintf(a) & 0xffu) | (((unsigned)(int)__builtin_rintf(b) & 0xffu) << 8) | (((unsigned)(int)__builtin_rintf(c) & 0xffu) << 16) | ((unsigned)(int)__builtin_rintf(d) << 24);
}
__device__ __forceinline__ void p0_q8_item(const float* W, size_t ldw, int src_col, const float* kscale, const float* cmax, float* sw, signed char* WT, int K, int dst_row, int k0, LAS unsigned char* scr, int lane) {
    const int c = lane & 15, r = lane >> 4;
    const GAS float* src = (const GAS float*)W + (size_t)(k0 + 16 * r) * ldw + src_col + 4 * c;
    f32x4 v[16];
#pragma unroll
    for (int i = 0; i < 16; ++i) v[i] = __builtin_nontemporal_load((const GAS f32x4*)(src + (size_t)i * ldw));
    f32x4 cm = *(const GAS f32x4*)((const GAS float*)cmax + dst_row + 4 * c);
#pragma unroll
    for (int j = 0; j < 4; ++j) cm[j] = cm[j] > 0.f ? cm[j] : 1.0f;
    if (kscale) {
#pragma unroll
    for (int q = 0; q < 4; ++q) { const f32x4 sc = *(const GAS f32x4*)((const GAS float*)kscale + k0 + 16 * r + 4 * q);
        v[4 * q] = v[4 * q] * sc.x; v[4 * q + 1] = v[4 * q + 1] * sc.y; v[4 * q + 2] = v[4 * q + 2] * sc.z; v[4 * q + 3] = v[4 * q + 3] * sc.w; } }
#pragma unroll
    for (int j = 0; j < 4; ++j) { const float inv = 127.0f / cm[j]; v4u o;
        o.x = q8pack4(v[0][j] * inv, v[1][j] * inv, v[2][j] * inv, v[3][j] * inv); o.y = q8pack4(v[4][j] * inv, v[5][j] * inv, v[6][j] * inv, v[7][j] * inv);
        o.z = q8pack4(v[8][j] * inv, v[9][j] * inv, v[10][j] * inv, v[11][j] * inv); o.w = q8pack4(v[12][j] * inv, v[13][j] * inv, v[14][j] * inv, v[15][j] * inv);
        *(LAS v4u*)(scr + (4 * c + j) * 80 + r * 16) = o; }
    LDS_WAIT(); asm volatile("" ::: "memory");
#pragma unroll
    for (int i = 0; i < 4; ++i) { const int n = (lane >> 2) + 16 * i; const v4u o = *(const LAS v4u*)(scr + n * 80 + (lane & 3) * 16);
        *(GAS v4u*)(WT + (size_t)(dst_row + n) * K + k0 + 16 * (lane & 3)) = o; }
    if (k0 == 0 && r == 0) *(GAS f32x4*)((GAS float*)sw + dst_row + 4 * c) = cm * (1.0f / 127.0f);
    LDS_WAIT(); asm volatile("" ::: "memory");
}

#ifndef ATTN_NAIVE
#define ATTN_NAIVE 0
#endif
#ifndef S5_NAIVE
#define S5_NAIVE 0
#endif
#define PROBE_DUP -1
#define OUT_I8 0
#ifndef MK_ONE_LAUNCH
#define MK_ONE_LAUNCH 1
#endif
struct Args { const float* in[N_IN]; float* out; unsigned char* ws; int ph_lo, ph_hi, li, pad; };

__device__ __forceinline__ void sincos_small(float x, float& s, float& c) {
    const float k = rintf(x * 0.6366197723675814f);
    float r = fmaf(-k, 1.5707962512969971f, x); r = fmaf(-k, 7.549789415861596e-08f, r);
    const float r2 = r * r;
    const float sp = r + r * r2 * (-1.6666667e-1f + r2 * (8.3333333e-3f + r2 * (-1.9841270e-4f + r2 * 2.7557319e-6f)));
    const float cp = 1.0f + r2 * (-0.5f + r2 * (4.1666667e-2f + r2 * (-1.3888889e-3f + r2 * (2.4801587e-5f + r2 * -2.7557319e-7f))));
    const int q = ((int)k) & 3;
    s = (q == 0) ? sp : (q == 1) ? cp : (q == 2) ? -sp : -cp;
    c = (q == 0) ? cp : (q == 1) ? -sp : (q == 2) ? -cp : sp;
}
__device__ __forceinline__ void naive_s5_item(int b, int g, int p, const bf16* __restrict__ S5IN, const float* lam_re, const float* lam_im, const float* log_step, const float* b_re, const float* b_im,
                                               const float* c_re, const float* c_im, const float* dd, bf16* __restrict__ G) {
    const float lr = lam_re[g * 64 + p], li = lam_im[g * 64 + p], dt = __expf(log_step[g]);
    const float mag = __expf(lr * dt); float sn, cs; sincos_small(li * dt, sn, cs);
    const float lbr = mag * cs, lbi = mag * sn, den = lr * lr + li * li, nr = lbr - 1.0f;
    const float facr = (nr * lr + lbi * li) / den, faci = (lbi * lr - nr * li) / den;
    float Bbr[16], Bbi[16], Cr[16], Ci[16];
#pragma unroll
    for (int i = 0; i < 16; ++i) { const float br = b_re[(g * 64 + p) * 16 + i], bi = b_im[(g * 64 + p) * 16 + i];
        Bbr[i] = facr * br - faci * bi; Bbi[i] = facr * bi + faci * br; Cr[i] = c_re[(g * 16 + i) * 64 + p]; Ci[i] = c_im[(g * 16 + i) * 64 + p]; }
    const float dl = dd[g * 16 + (p & 15)];
    float xr = 0.f, xi = 0.f;
    for (int t = 0; t < SEQ; ++t) {
        const size_t ro = (size_t)(b * SEQ + t) * S5W + g * 16, ri = ((size_t)g * M + b * SEQ + t) * 16;
        const v4u w0 = *(const v4u*)(S5IN + ri), w1 = *(const v4u*)(S5IN + ri + 8);
        float u[16];
        u[0] = __uint_as_float(w0.x << 16); u[1] = __uint_as_float(w0.x & 0xffff0000u); u[2] = __uint_as_float(w0.y << 16); u[3] = __uint_as_float(w0.y & 0xffff0000u);
        u[4] = __uint_as_float(w0.z << 16); u[5] = __uint_as_float(w0.z & 0xffff0000u); u[6] = __uint_as_float(w0.w << 16); u[7] = __uint_as_float(w0.w & 0xffff0000u);
        u[8] = __uint_as_float(w1.x << 16); u[9] = __uint_as_float(w1.x & 0xffff0000u); u[10] = __uint_as_float(w1.y << 16); u[11] = __uint_as_float(w1.y & 0xffff0000u);
        u[12] = __uint_as_float(w1.z << 16); u[13] = __uint_as_float(w1.z & 0xffff0000u); u[14] = __uint_as_float(w1.w << 16); u[15] = __uint_as_float(w1.w & 0xffff0000u);
        float bur = 0.f, bui = 0.f;
#pragma unroll
        for (int i = 0; i < 16; ++i) { bur += Bbr[i] * u[i]; bui += Bbi[i] * u[i]; }
        const float nxr = lbr * xr - lbi * xi + bur, nxi = lbr * xi + lbi * xr + bui; xr = nxr; xi = nxi;
        float ysel = 0.f, usel = 0.f;
#pragma unroll
        for (int i = 0; i < 16; ++i) { const float tot = wave_sum(Cr[i] * xr - Ci[i] * xi); if ((p & 15) == i) { ysel = tot; usel = u[i]; } }
        const float y = ysel + dl * usel;
        if (p < 16) { const float gv = gelu_tanh(y); G[ro + p] = (bf16)f2bf(gv); }
    }
}


typedef float f32x2s __attribute__((ext_vector_type(2)));
__device__ __forceinline__ f32x2s cmul(f32x2s a, f32x2s b) { return (f32x2s){a.x * b.x - a.y * b.y, a.x * b.y + a.y * b.x}; }
__device__ __forceinline__ void s5_precompute(int g, const float* lam_re, const float* lam_im, const float* log_step, const float* b_re, const float* b_im, const float* c_re, const float* c_im, const float* dd,
                                              bf16* KT, bf16* ET, bf16* OM, float* LBL, LAS unsigned char* L) {
    LAS f32x2s* PW = (LAS f32x2s*)L;
    LAS f32x2s* BB = PW + 33 * 64;
    LAS f32x2s* CC = BB + 64 * 16;
    const int t = threadIdx.x;
    if (t < 64) { const int p = t;
        const float lr = lam_re[g * 64 + p], li = lam_im[g * 64 + p], dt = __expf(log_step[g]);
        const float mag = __expf(lr * dt); float sn, cs; sincos_small(li * dt, sn, cs);
        const f32x2s lb = {mag * cs, mag * sn}; const float den = lr * lr + li * li, nr = lb.x - 1.0f;
        const f32x2s fac = {(nr * lr + lb.y * li) / den, (lb.y * lr - nr * li) / den};
#pragma unroll 2
        for (int j = 0; j < 16; ++j) { const f32x2s bv = {b_re[(g * 64 + p) * 16 + j], b_im[(g * 64 + p) * 16 + j]}; BB[p * 16 + j] = cmul(fac, bv); }
#pragma unroll 2
        for (int i = 0; i < 16; ++i) CC[i * 64 + p] = (f32x2s){c_re[(g * 16 + i) * 64 + p], c_im[(g * 16 + i) * 64 + p]};
        f32x2s pw = {1.f, 0.f};
#pragma unroll 1
        for (int d = 0; d <= 32; ++d) { PW[d * 64 + p] = pw; pw = cmul(pw, lb); }
        const f32x2s l32 = PW[32 * 64 + p]; LBL[(g * 64 + p) * 2] = l32.x; LBL[(g * 64 + p) * 2 + 1] = l32.y;
    }
    __syncthreads();
    bf16* KTg = KT + (size_t)g * S5L * 256; bf16* ETg = ET + (size_t)g * 128 * S5K; bf16* OMg = OM + (size_t)g * S5K * 128;
#pragma unroll 1
    for (int idx = t; idx < S5L * 256; idx += NWAVES * 64) { const int d = idx >> 8, i = (idx >> 4) & 15, j = idx & 15; float a = 0.f;
#pragma unroll 4
        for (int p = 0; p < 64; ++p) { const f32x2s cp = cmul(CC[i * 64 + p], PW[d * 64 + p]), bv = BB[p * 16 + j]; a += cp.x * bv.x - cp.y * bv.y; }
        if (d == 0 && i == j) a += dd[g * 16 + i];
        KTg[idx] = (bf16)f2bf(a); }
#pragma unroll 2
    for (int idx = t; idx < 128 * S5K; idx += NWAVES * 64) { const int n = idx >> 9, k = idx & 511, p = n >> 1, sI = k >> 4, j = k & 15;
        const f32x2s v = cmul(PW[(31 - sI) * 64 + p], BB[p * 16 + j]); ETg[idx] = (bf16)f2bf((n & 1) ? v.y : v.x); }
#pragma unroll 2
    for (int idx = t; idx < S5K * 128; idx += NWAVES * 64) { const int row = idx >> 7, n = idx & 127, p = n >> 1, tt = row >> 4, i = row & 15;
        const f32x2s v = cmul(CC[i * 64 + p], PW[(tt + 1) * 64 + p]); OMg[idx] = (bf16)f2bf((n & 1) ? -v.y : v.x); }
    __syncthreads();
}

constexpr int S5_KTL_OFF = 65536 + 32768 + 4096 + 1024;
template <int T> __device__ __forceinline__ void s5_out_steps(const bf16x8 (&af)[16], const bf16x8 (&xf)[4], bf16x8 (&om)[4][4], const LAS unsigned char* kl, const bf16* op, bf16* gout, unsigned goff, int kq) {
    if constexpr (T < S5L) {
        if constexpr (T + 3 < S5L) {
#pragma unroll
            for (int ks = 0; ks < 4; ++ks) om[(T + 3) & 3][ks] = *(const bf16x8*)(op + (size_t)(T + 3) * 16 * 128 + 32 * ks); }
        f32x4 acc = {0.f, 0.f, 0.f, 0.f};
#pragma unroll
        for (int ks = 0; ks <= (T >> 1); ++ks) { const int d = T - 2 * ks;
            bf16x8 bfr = *(const LAS bf16x8*)(kl + d * 512);
            if (d == 0) { const bf16x8 zero8 = {0, 0, 0, 0, 0, 0, 0, 0}; bfr = (kq >> 1) ? zero8 : bfr; }
            acc = __builtin_amdgcn_mfma_f32_16x16x32_bf16(af[ks], bfr, acc, 0, 0, 0); }
#pragma unroll
        for (int ks = 0; ks < 4; ++ks) acc = __builtin_amdgcn_mfma_f32_16x16x32_bf16(xf[ks], om[T & 3][ks], acc, 0, 0, 0);
#pragma unroll
        for (int rg = 0; rg < 4; ++rg) { GAS bf16* gp = (GAS bf16*)gout + (size_t)(rg * S5L + T) * S5W; asm volatile("" : "+s"(gp)); gp[goff] = (bf16)f2bf(gelu_tanh(acc[rg])); }
        __builtin_amdgcn_sched_barrier(0);
        s5_out_steps<T + 1>(af, xf, om, kl, op, gout, goff, kq);
    }
}
template <int VAR> __device__ __forceinline__ void s5_item(int b, int g, const bf16* S5IN, const bf16* KT, const bf16* ET, const bf16* OM, const float* LBL, bf16* GO, LAS unsigned char* L, int wave) {
    const int lane = threadIdx.x & 63, fr = lane & 15, kq = lane >> 4;
    LAS float* EL = (LAS float*)L;
    LAS bf16* XIN = (LAS bf16*)(L + 65536);
    LAS f32x2s* PE = (LAS f32x2s*)(L + 65536 + 32768);
    const bf16* KTg = KT + (size_t)g * S5L * 256; const bf16* ETg = ET + (size_t)g * 128 * S5K; const bf16* OMg = OM + (size_t)g * S5K * 128;
    { const v4u* src = (const v4u*)KTg; LAS v4u* dst = (LAS v4u*)(L + S5_KTL_OFF);
      dst[threadIdx.x] = src[threadIdx.x]; dst[threadIdx.x + NWAVES * 64] = src[threadIdx.x + NWAVES * 64]; }
    const bf16* arow = S5IN + ((size_t)g * M + (size_t)b * SEQ + (size_t)(16 * wave + fr) * S5L) * 16;
    bf16x8 af[16];
#pragma unroll
    for (int ks = 0; ks < 16; ++ks) af[ks] = *(const bf16x8*)(arow + (2 * ks + (kq >> 1)) * 16 + 8 * (kq & 1));
    if constexpr (VAR != 2) {
#pragma unroll 2
    for (int nt = 0; nt < 8; ++nt) { f32x4 acc = {0.f, 0.f, 0.f, 0.f}; const bf16* bp = ETg + (size_t)(nt * 16 + fr) * S5K + 8 * kq;
#pragma unroll
        for (int ks = 0; ks < 16; ++ks) acc = __builtin_amdgcn_mfma_f32_16x16x32_bf16(af[ks], *(const bf16x8*)(bp + 32 * ks), acc, 0, 0, 0);
#pragma unroll
        for (int rg = 0; rg < 4; ++rg) EL[(16 * wave + 4 * kq + rg) * 128 + nt * 16 + fr] = acc[rg]; }
    }
    __syncthreads();
    { const int p = lane; const f32x2s lbl = {LBL[(g * 64 + p) * 2], LBL[(g * 64 + p) * 2 + 1]};
      f32x2s loc[16]; f32x2s x = {0.f, 0.f};
#pragma unroll
      for (int i = 0; i < 16; ++i) { const f32x2s e = *(const LAS f32x2s*)(EL + (16 * wave + i) * 128 + 2 * p); x = cmul(lbl, x); x.x += e.x; x.y += e.y; loc[i] = x; }
      PE[wave * 64 + p] = x;
      __syncthreads();
      f32x2s l16 = cmul(lbl, lbl); l16 = cmul(l16, l16); l16 = cmul(l16, l16); l16 = cmul(l16, l16);
      f32x2s cin = {0.f, 0.f};
      for (int q = 0; q < wave; ++q) { const f32x2s pe = PE[q * 64 + p]; cin = cmul(l16, cin); cin.x += pe.x; cin.y += pe.y; }
      f32x2s carry = cin, prev = {0.f, 0.f};
#pragma unroll
      for (int i = 0; i < 16; ++i) { const float xr = prev.x + carry.x, xi = prev.y + carry.y; *(LAS unsigned*)(XIN + (16 * wave + i) * 128 + 2 * p) = pk2(xr, xi); prev = loc[i]; carry = cmul(carry, lbl); }
    }
    __syncthreads();
    if constexpr (VAR == 1) { __syncthreads(); return; }
    bf16x8 xf[4];
#pragma unroll
    for (int ks = 0; ks < 4; ++ks) xf[ks] = *(const LAS bf16x8*)(XIN + (16 * wave + fr) * 128 + 32 * ks + 8 * kq);
    const LAS unsigned char* kl = L + S5_KTL_OFF + fr * 32 + 16 * (kq & 1) - 512 * (kq >> 1); const bf16* op = OMg + (size_t)fr * 128 + 8 * kq;
    bf16x8 om[4][4];
#pragma unroll
    for (int tt = 0; tt < 3; ++tt)
#pragma unroll
        for (int ks = 0; ks < 4; ++ks) om[tt][ks] = *(const bf16x8*)(op + (size_t)tt * 16 * 128 + 32 * ks);
    bf16* gout = GO + ((size_t)b * SEQ + (size_t)(16 * wave) * S5L) * S5W + g * 16; const unsigned goff = (unsigned)(4 * kq * S5L) * S5W + fr;
    s5_out_steps<0>(af, xf, om, kl, op, gout, goff, kq);
    __syncthreads();
}

__device__ __forceinline__ void naive_attn_item(const bf16* QKV, const float* FK, bf16* O, LAS float* sc, int item, int lane) {
    const int row = item >> 4, h = item & 15, b = row / SEQ, t = row % SEQ;
    const bf16* q = QKV + (size_t)row * NQKV + h * HD;
    const bf16* Kb = QKV + (size_t)b * SEQ * NQKV + FOXW + h * HD;
    const bf16* Vb = QKV + (size_t)b * SEQ * NQKV + 2 * FOXW + h * HD;
    const float* fk = FK + (size_t)(b * NH + h) * SEQ;
    float mx = -INFINITY;
    for (int j0 = 0; j0 <= t; j0 += 64) { const int j = j0 + lane;
        if (j <= t) { const bf16* kr = Kb + (size_t)j * NQKV; float s = 0.f;
            for (int c = 0; c < 16; ++c) { const v4u kw = *(const v4u*)(kr + c * 8), qw = *(const v4u*)(q + c * 8);
                s += __uint_as_float(kw.x << 16) * __uint_as_float(qw.x << 16) + __uint_as_float(kw.x & 0xffff0000u) * __uint_as_float(qw.x & 0xffff0000u);
                s += __uint_as_float(kw.y << 16) * __uint_as_float(qw.y << 16) + __uint_as_float(kw.y & 0xffff0000u) * __uint_as_float(qw.y & 0xffff0000u);
                s += __uint_as_float(kw.z << 16) * __uint_as_float(qw.z << 16) + __uint_as_float(kw.z & 0xffff0000u) * __uint_as_float(qw.z & 0xffff0000u);
                s += __uint_as_float(kw.w << 16) * __uint_as_float(qw.w << 16) + __uint_as_float(kw.w & 0xffff0000u) * __uint_as_float(qw.w & 0xffff0000u); }
            s += fk[j]; sc[j] = s; mx = fmaxf(mx, s); } }
    mx = wave_max(mx);
    LDS_WAIT(); asm volatile("" ::: "memory");
    float sum = 0.f;
    for (int j = lane; j <= t; j += 64) { const float p = exp2f(sc[j] - mx); sc[j] = p; sum += p; }
    sum = wave_sum(sum);
    LDS_WAIT(); asm volatile("" ::: "memory");
    float a0 = 0.f, a1 = 0.f;
    for (int j = 0; j <= t; ++j) { const float p = sc[j]; const unsigned vw = *(const unsigned*)(Vb + (size_t)j * NQKV + 2 * lane);
        a0 += p * __uint_as_float(vw << 16); a1 += p * __uint_as_float(vw & 0xffff0000u); }
    const float inv = 1.0f / sum;
    *(unsigned*)(O + (size_t)row * ASP + h * HD + 2 * lane) = pk2(a0 * inv, a1 * inv);
    LDS_WAIT(); asm volatile("" ::: "memory");
}

__global__ void __launch_bounds__(NWAVES * 64, 2) fwd(Args args) {
    extern __shared__ __attribute__((aligned(16))) unsigned char lds[];
    LAS unsigned char* L = (LAS unsigned char*)lds;
    volatile LAS unsigned* MISC = (volatile LAS unsigned*)(L + MISC_OFF);
    const int wave = __builtin_amdgcn_readfirstlane(threadIdx.x >> 6);
#define tid ((int)threadIdx.x)
#define LANE_DECL const int lane = threadIdx.x & 63
    const int G = gridDim.x, bx = blockIdx.x;
    const int vcu = (G % 8 == 0) ? (bx % 8) * (G / 8) + bx / 8 : bx;
    const int gw = vcu * NWAVES + wave, NGW = G * NWAVES;
    unsigned char* ws = args.ws;
    gu32* ctl = (gu32*)(ws + WS_CTL);
    for (int u = threadIdx.x; u < (LDS_BYTES - LDSCTL_OFF) / 4; u += NWAVES * 64) ((LAS unsigned*)(L + LDSCTL_OFF))[u] = 0u;
    __syncthreads();
    const int lo = args.ph_lo, hi = args.ph_hi;
    XcdBarrier bar; bar.bar = (unsigned*)(ctl + CW_BAR) + args.li * XCD_BAR_WORDS; bar.x = 0; bar.st = nullptr;
    if (hi - lo > 1 || lo == 0 || (lo <= 5 && 5 < hi)) bar = xcd_barrier_post((unsigned*)(ctl + CW_BAR) + args.li * XCD_BAR_WORDS, MISC + 8);
#define IN(k) (lo <= (k) && (k) < hi)
#define BOTH(k) (IN(k) && IN((k) + 1))
#define GRID_BAR() xcd_barrier(bar)

    const float* x = args.in[I_X];
    float* out = args.out;
    float* RS1 = (float*)(ws + WS_RS1); float* RS2 = (float*)(ws + WS_RS2); float* LS = (float*)(ws + WS_LS); float* FK = (float*)(ws + WS_FK); float* HP = (float*)(ws + WS_HP);
    bf16* WF = (bf16*)(ws + WS_WF); float* RSX = (float*)(ws + WS_RSX); float* SW = (float*)(ws + WS_SW);
    signed char* XQ = (signed char*)(ws + WS_RB); signed char* WG8 = (signed char*)(ws + WS_WG8); gu32* CMAX = ctl + CW_CMAX; gu32* CMAXO = ctl + CW_CMAXO;
    signed char* MQ = (signed char*)(ws + WS_RB); signed char* WO8 = (signed char*)(ws + WS_WO); float* SWO = (float*)(ws + WS_SWO); float* SAM = (float*)(ws + WS_SAM);
    bf16* WGLU = (bf16*)(ws + WS_WGLU); bf16* WCAT = (bf16*)(ws + WS_WPF);
    signed char* WGUX = (signed char*)(ws + WS_WGU); bf16* WD = (bf16*)(ws + WS_WD);
    signed char* AQ = (signed char*)(ws + WS_RB); float* SAH = (float*)(ws + WS_SAH); float* SBGU = (float*)(ws + WS_SBGU); gu32* CMAXGU = ctl + CW_CMAXGU;
    bf16* XB = (bf16*)(ws + WS_RA); bf16* HB = (bf16*)(ws + WS_RA); bf16* MERGED = (bf16*)(ws + WS_QKV);
    bf16* QKV = (bf16*)(ws + WS_QKV); bf16* S5IN = (bf16*)(ws + WS_S5IN); unsigned char* GATES = (unsigned char*)(ws + WS_GATES); bf16* ACT = (bf16*)(ws + WS_ACT);
    bf16* AS = (bf16*)(ws + WS_ATTN); bf16* GB = (bf16*)(ws + WS_G);
    bf16* KT = (bf16*)(ws + WS_KT); bf16* ET = (bf16*)(ws + WS_ET); bf16* OM = (bf16*)(ws + WS_OM); float* LBL = (float*)(ws + WS_LBL);

    if (IN(0)) {
        LANE_DECL;
        {
            constexpr int IA1 = (DM / 64) * (N1 / 64), IA2 = OUT_I8 ? (DM / 64) * (DM / 64) : 0, IA3 = (KQ / 64) * (NGU / 64);
            for (int it = gw; it < IA1 + IA2 + IA3; it += NGW) { const int kind = it < IA1 ? 0 : it < IA1 + IA2 ? 1 : 2; const int i2 = kind == 0 ? it : kind == 1 ? it - IA1 : it - IA1 - IA2, nbl = kind == 0 ? N1 / 64 : kind == 1 ? DM / 64 : NGU / 64,
                          kb = i2 / nbl, nb = i2 % nbl, c = lane & 15, r = lane >> 4, dr = 64 * nb;
                const size_t ldw = kind == 0 ? INCOLS : kind == 1 ? DM : NGU;
                const int scol = kind == 0 ? (dr < NQKV ? dr : dr + 16) : kind == 1 ? dr : ((dr & 255) < 128 ? 128 * (dr >> 8) + (dr & 255) : DFF + 128 * (dr >> 8) + ((dr & 255) - 128));
                const GAS float* src = (const GAS float*)(kind == 0 ? args.in[I_WIN] : kind == 1 ? args.in[I_WOUT] : args.in[I_WGU]) + (size_t)(64 * kb + 16 * r) * ldw + scol + 4 * c;
                f32x4 v[16];
#pragma unroll
                for (int i = 0; i < 16; ++i) v[i] = __builtin_nontemporal_load((const GAS f32x4*)(src + (size_t)i * ldw));
                f32x4 mx = {0.f, 0.f, 0.f, 0.f};
#pragma unroll
                for (int q = 0; q < 4; ++q) { f32x4 sc = {1.f, 1.f, 1.f, 1.f}; if (kind != 1) sc = *(const GAS f32x4*)((const GAS float*)(kind == 0 ? args.in[I_GMIX] : args.in[I_GFFN]) + 64 * kb + 16 * r + 4 * q);
                    mx = __builtin_elementwise_max(mx, __builtin_elementwise_abs(v[4 * q] * sc.x)); mx = __builtin_elementwise_max(mx, __builtin_elementwise_abs(v[4 * q + 1] * sc.y));
                    mx = __builtin_elementwise_max(mx, __builtin_elementwise_abs(v[4 * q + 2] * sc.z)); mx = __builtin_elementwise_max(mx, __builtin_elementwise_abs(v[4 * q + 3] * sc.w)); }
                gu32* cmx = (kind == 0 ? CMAX : kind == 1 ? CMAXO : CMAXGU) + dr + 4 * c;
#pragma unroll
                for (int j = 0; j < 4; ++j) { float m_ = mx[j]; m_ = fmaxf(m_, __shfl_xor(m_, 16)); m_ = fmaxf(m_, __shfl_xor(m_, 32));
                    if (r == 0) __hip_atomic_fetch_max(cmx + j, __float_as_uint(m_), RLX_AGENT); }
            }
        }
        GRID_BAR();
        for (int g = vcu; g < S5G; g += G)
            s5_precompute(g, args.in[I_LRE], args.in[I_LIM], args.in[I_LSTEP], args.in[I_BRE], args.in[I_BIM], args.in[I_CRE], args.in[I_CIM], args.in[I_SD], KT, ET, OM, LBL, L + RING_OFF);
        LAS unsigned char* scr = L + RING_OFF + wave * 16384;
        constexpr int IG8 = (DM / 64) * (N1 / 64), IGLU = (S5W / 64) * (S5W / 64), IPF = (FOXW / 64) * (DM / 64), IPS = (S5W / 64) * (DM / 64), IO = (DM / 64) * (DM / 64),
                      IGU = (DM / 64) * (NGU / 64);
        constexpr int NITEMS = IG8 + IGLU + IPF + IPS + IO + IGU;
        for (int idx = bx * (NWAVES * 64) + tid; idx < 16 * DM; idx += G * NWAVES * 64) { const int k = idx >> 4, h = idx & 15;
            WF[(size_t)h * DM + k] = (bf16)f2bf(args.in[I_WIN][(size_t)k * INCOLS + NQKV + h] * args.in[I_GMIX][k]); }
        for (int m = gw; m < M; m += NGW) {
            const GAS f32x4* xr = (const GAS f32x4*)(x + (size_t)m * DM) + lane;
            f32x4 v[16]; float s = 0.f;
#pragma unroll
            for (int j = 0; j < 16; ++j) { v[j] = __builtin_nontemporal_load(xr + 64 * j); s += (v[j].x * v[j].x + v[j].y * v[j].y) + (v[j].z * v[j].z + v[j].w * v[j].w); }
            const float tot = wave_sum(s);
            const float rs1 = 1.0f / sqrtf(tot * (1.0f / DM) + RMS_EPS);
            float ax = 0.f;
#pragma unroll
            for (int j = 0; j < 16; ++j) ax = fmaxf(ax, fmaxf(fmaxf(fabsf(v[j].x), fabsf(v[j].y)), fmaxf(fabsf(v[j].z), fabsf(v[j].w))));
            ax = wave_max(ax); const float qi = ax > 0.f ? 127.0f / ax : 0.f;
            if (lane == 0) { RS1[m] = rs1; RSX[m] = rs1 * ax * (1.0f / 127.0f); }
            GAS unsigned* q4 = (GAS unsigned*)(XQ + (size_t)m * DM) + lane;
#pragma unroll
            for (int j = 0; j < 16; ++j) q4[64 * j] = q8pack4(v[j].x * qi, v[j].y * qi, v[j].z * qi, v[j].w * qi);
            GAS unsigned long long* o8 = (GAS unsigned long long*)(XB + (size_t)m * DM) + lane;
#pragma unroll
            for (int j = 0; j < 16; ++j) o8[64 * j] = (unsigned long long)pk2(v[j].x, v[j].y) | ((unsigned long long)pk2(v[j].z, v[j].w) << 32);
        }
        for (int it = gw; it < NITEMS; it += NGW) {
            int r = it;
            if (r < IGU) { const int nblk = NGU / 64, kb = r / nblk, nb = r % nblk, dr = 64 * nb, t = dr >> 8, w = dr & 255;
                const int scol = w < 128 ? 128 * t + w : DFF + 128 * t + (w - 128);
                if (64 * kb < KQ) p0_q8_item(args.in[I_WGU], NGU, scol, args.in[I_GFFN], (const float*)CMAXGU, SBGU, WGUX, PAGU, dr, 64 * kb, scr, lane);
                else p0_tr_item(args.in[I_WGU], NGU, scol, args.in[I_GFFN], (bf16*)WGUX, PAGU / 2, dr, 64 * kb, scr, lane, -(KQ / 2), (const float*)CMAXGU);
                continue; } r -= IGU;
            if (r < IO) { const int nblk = DM / 64, kb = r / nblk, nb = r % nblk; p0_tr_item(args.in[I_WOUT], DM, 64 * nb, nullptr, (bf16*)WO8, DM, 64 * nb, 64 * kb, scr, lane); continue; } r -= IO;
            if (r < IPF) { const int nblk = DM / 64, kb = r / nblk, nb = r % nblk; p0_tr_item(args.in[I_WPF], DM, 64 * nb, nullptr, WCAT, ASP, 64 * nb, 64 * kb, scr, lane, 0); continue; } r -= IPF;
            if (r < IPS) { const int nblk = DM / 64, kb = r / nblk, nb = r % nblk; p0_tr_item(args.in[I_WPS], DM, 64 * nb, nullptr, WCAT, ASP, 64 * nb, 64 * kb, scr, lane, FOXW); continue; } r -= IPS;
            if (r < IGLU) { const int nblk = S5W / 64, kb = r / nblk, nb = r % nblk; p0_tr_item(args.in[I_WGLU], S5W, 64 * nb, nullptr, WGLU, S5W, 64 * nb, 64 * kb, scr, lane); continue; } r -= IGLU;
            { const int nblk = N1 / 64, kb = r / nblk, nb = r % nblk, dr = 64 * nb; p0_q8_item(args.in[I_WIN], INCOLS, dr < NQKV ? dr : dr + 16, args.in[I_GMIX], (const float*)CMAX, SW, WG8, DM, dr, 64 * kb, scr, lane); }
        }
        if (BOTH(0)) GRID_BAR();
    }

    if (IN(1)) {
        for (int it = vcu; it < M / 64; it += G) {
            LANE_DECL;
            const int r0 = it * 64 + (wave & 3) * 16, kh = (wave >> 2) * (DM / 2);
            const bf16* ap = XB + (size_t)(r0 + (lane & 15)) * DM + kh + 8 * (lane >> 4);
            const bf16* bp = WF + (size_t)(lane & 15) * DM + kh + 8 * (lane >> 4);
            f32x4 acc = {0.f, 0.f, 0.f, 0.f};
#pragma unroll 1
            for (int k0 = 0; k0 < DM / 2; k0 += 512) { bf16x8 a[16], b[16];
#pragma unroll
                for (int j = 0; j < 16; ++j) { a[j] = *(const bf16x8*)(ap + k0 + 32 * j); b[j] = *(const bf16x8*)(bp + k0 + 32 * j); }
#pragma unroll
                for (int j = 0; j < 16; ++j) acc = __builtin_amdgcn_mfma_f32_16x16x32_bf16(a[j], b[j], acc, 0, 0, 0); }
            LAS f32x4* px = (LAS f32x4*)(L + RING_OFF) + (wave & 3) * 64 + lane;
            if (wave >= 4) *px = acc;
            __syncthreads();
            if (wave < 4) { acc = acc + *px;
                const int h = lane & 15; const float bfg = args.in[I_BF][h];
#pragma unroll
                for (int rg = 0; rg < 4; ++rg) { const int row = r0 + 4 * (lane >> 4) + rg; LS[((size_t)(row >> 12) * NH + h) * SEQ + (row & (SEQ - 1))] = log_sigmoid_f(acc[rg] * RS1[row] + bfg); } }
            __syncthreads();
        }
        pg8::Gemm g{(const bf16*)XQ, (const bf16*)WG8, M, N1, DM / 2}; pg8::StaticOrder S; S.init(M, N1, G, bx);
        pg8::EpiZ E{QKV, S5IN, GATES, RSX, SW, args.in[I_BG], args.in[I_QN], args.in[I_KN], QSCALE, RMS_EPS, (LAS float*)(L + QKP_OFF)};
        pg8::gemm_phase<pg8::EpiZ, pg8::StaticOrder, true, true>(L + RING_OFF, g, S, E);
        if (BOTH(1)) GRID_BAR();
    }

    if (IN(2)) {
        LANE_DECL;
        if (gw < BATCH * NH) {
            const f32x4* base = (const f32x4*)(LS + (size_t)gw * SEQ + 64 * lane);
            f32x4 lv[16]; float s = 0.f;
#pragma unroll
            for (int i = 0; i < 16; ++i) lv[i] = base[i];
#pragma unroll
            for (int i = 0; i < 16; ++i) s += (lv[i].x + lv[i].y) + (lv[i].z + lv[i].w);
            float incl = s;
#pragma unroll
            for (int o = 1; o < 64; o <<= 1) { const float t = __shfl_up(incl, o); if (lane >= o) incl += t; }
            float run = incl - s;
            f32x4* fo = (f32x4*)(FK + (size_t)gw * SEQ + 64 * lane);
#pragma unroll
            for (int i = 0; i < 16; ++i) { f32x4 o; run += lv[i].x; o.x = -run * LOG2E; run += lv[i].y; o.y = -run * LOG2E; run += lv[i].z; o.z = -run * LOG2E; run += lv[i].w; o.w = -run * LOG2E; fo[i] = o; }
        }
#if !S5_NAIVE
        for (int it = vcu; it < BATCH * S5G; it += G) s5_item<0>(it & (BATCH - 1), it / BATCH, S5IN, KT, ET, OM, LBL, GB, L + RING_OFF, wave);
#else
        if (wave == 0) for (int it = vcu; it < BATCH * S5G; it += G)
            naive_s5_item(it >> 6, it & 63, lane, S5IN, args.in[I_LRE], args.in[I_LIM], args.in[I_LSTEP], args.in[I_BRE], args.in[I_BIM], args.in[I_CRE], args.in[I_CIM], args.in[I_SD], GB);
#endif
        if (BOTH(2)) GRID_BAR();
    }

    if (IN(3)) {
#if ATTN_NAIVE
        { LANE_DECL; LAS float* sc = (LAS float*)(L + RING_OFF + wave * 16384);
          for (int item = gw; item < M * NH; item += NGW) naive_attn_item(QKV, FK, AS, sc, item, lane); }
#else
        {
            typedef fox::BlockRef<fox::bf16, fox::bf16> BR;
            constexpr int NQB = SEQ / fox::QB, TOTAL = NQB * BATCH * NH;
            float lim;
            { const int ln = threadIdx.x & 63; float mq = fmaxf(fabsf(args.in[I_QN][ln]), fabsf(args.in[I_QN][ln + 64])), mk = fmaxf(fabsf(args.in[I_KN][ln]), fabsf(args.in[I_KN][ln + 64]));
              mq = wave_max(mq); mk = wave_max(mk); lim = 2.04f * (float)HD * QSCALE * mq * mk + 40.0f; }
            auto mkref = [&](int it) { const int qb = NQB - 1 - (it >> 6), bh = it & 63, b = bh / NH, h = bh % NH; BR r;
                r.Q = (const fox::bf16*)QKV + ((size_t)b * SEQ + (size_t)qb * fox::QB) * NQKV + h * HD;
                r.K = (const fox::bf16*)QKV + (size_t)b * SEQ * NQKV + FOXW + h * HD; r.V = (const fox::bf16*)QKV + (size_t)b * SEQ * NQKV + 2 * FOXW + h * HD;
                r.O = (fox::bf16*)AS + ((size_t)b * SEQ + (size_t)qb * fox::QB) * ASP + h * HD; r.F = FK + (size_t)bh * SEQ; r.P0 = qb * fox::QB; r.NT = fox::fox_nt(r.F, r.P0, lim); r.LH = 0.5f * (lim - 40.0f) + 40.0f; return r; };
            gu32* qctr = ctl + CW_ATTNQ + 64 * args.li;
            if (threadIdx.x == 0) { MISC[12] = __hip_atomic_fetch_add(qctr, 1u, RLX_AGENT); MISC[13] = __hip_atomic_fetch_add(qctr, 1u, RLX_AGENT); }
            __syncthreads();
            int ic = (int)MISC[12], in_ = (int)MISC[13], par = 0;
            __syncthreads();
            if (ic < TOTAL) {
                BR cur = mkref(ic); fox::Seam<fox::bf16> Sm;
                fox::causal_swa_prime<fox::bf16, fox::bf16>(cur, SEQ, (char*)lds + RING_OFF, Sm);
                for (;;) {
                    const bool last = in_ >= TOTAL;
                    if (threadIdx.x == 0 && !last) MISC[12 + par] = __hip_atomic_fetch_add(qctr, 1u, RLX_AGENT);
                    const BR nxt = last ? cur : mkref(in_);
                    fox::causal_swa_block<fox::bf16, fox::bf16>(cur, nxt, SEQ, SEQ, (char*)lds + RING_OFF, Sm);
                    if (last) break;
                    cur = nxt; in_ = (int)MISC[12 + par]; par ^= 1;
                }
            }
        }
#endif
    }

    if (IN(4)) {
        pg8::Gemm g{GB, WGLU, M, S5W, S5W}; pg8::StaticOrder S; S.init(M, S5W, G, bx);
        pg8::EpiGlu E{GB, AS + FOXW, args.in[I_BGLU], S5W, ASP};
        pg8::gemm_phase<pg8::EpiGlu, pg8::StaticOrder, true, true>(L + RING_OFF, g, S, E);
        if (BOTH(4)) GRID_BAR();
    }

    if (IN(5)) {
        pg8::Gemm g{AS, WCAT, M, DM, ASP}; pg8::StaticOrder S; S.init(M, DM, G, bx);
        typedef pg8::EpiProjT<OUT_I8 != 0> EpiP; EpiP E{GATES, NGATE, DM, MERGED, DM, HP};
        pg8::gemm_phase<EpiP, pg8::StaticOrder, true, true>(L + RING_OFF, g, S, E);
#if OUT_I8
        GRID_BAR();
        {
            LANE_DECL;
            for (int m = gw; m < M; m += NGW) {
                const float ax = wave_max(HP[(size_t)m * 64 + lane]) * 1.004f;
                const float qi = ax > 0.f ? 127.0f / ax : 0.f;
                if (lane == 0) SAM[m] = ax * (1.0f / 127.0f);
                const GAS v4u* src = (const GAS v4u*)(MERGED + (size_t)m * DM) + lane;
                GAS unsigned long long* dst = (GAS unsigned long long*)(MQ + (size_t)m * DM) + lane;
                v4u w[8];
#pragma unroll
                for (int j = 0; j < 8; ++j) w[j] = src[64 * j];
#pragma unroll
                for (int j = 0; j < 8; ++j) { const unsigned lo = q8pack4(pg8::bf_lo(w[j].x) * qi, pg8::bf_hi(w[j].x) * qi, pg8::bf_lo(w[j].y) * qi, pg8::bf_hi(w[j].y) * qi),
                                                             hi2 = q8pack4(pg8::bf_lo(w[j].z) * qi, pg8::bf_hi(w[j].z) * qi, pg8::bf_lo(w[j].w) * qi, pg8::bf_hi(w[j].w) * qi);
                    dst[64 * j] = (unsigned long long)lo | ((unsigned long long)hi2 << 32); }
            }
        }
#endif
        if (BOTH(5)) GRID_BAR();
    }

    if (IN(6)) {
#if OUT_I8
        pg8::Gemm g{(const bf16*)MQ, (const bf16*)WO8, M, DM, DM / 2}; pg8::StaticOrder S; S.init(M, DM, G, bx);
        typedef pg8::EpiResid<false, false, true, true> EpiH;
        EpiH E{x, nullptr, nullptr, HB, HP, DM, SAM, SWO};
#else
        pg8::Gemm g{MERGED, (const bf16*)WO8, M, DM, DM}; pg8::StaticOrder S; S.init(M, DM, G, bx);
        typedef pg8::EpiResidP<false, false, true> EpiH;
        EpiH E{x, nullptr, nullptr, HB, HP, DM};
#endif
        pg8::gemm_phase<EpiH, pg8::StaticOrder, true, true>(L + RING_OFF, g, S, E);
        if (BOTH(6)) GRID_BAR();
    }

    if (IN(7)) {
        {
            LANE_DECL;
            constexpr int NCH = (KQ + 511) / 512, RB = 4;
            for (int m0 = gw; m0 < M; m0 += RB * NGW) {
                float hp[RB]; v4u w[RB][NCH];
#pragma unroll
                for (int r = 0; r < RB; ++r) { const int m = m0 + r * NGW; hp[r] = 0.f;
#pragma unroll
                    for (int j = 0; j < NCH; ++j) w[r][j] = (v4u){0u, 0u, 0u, 0u};
                    if (m < M) { hp[r] = HP[(size_t)m * 64 + lane]; const GAS v4u* src = (const GAS v4u*)(HB + (size_t)m * DM) + lane;
#pragma unroll
                        for (int j = 0; j < NCH; ++j) if (512 * j + 8 * lane < KQ) w[r][j] = src[64 * j]; } }
                asm volatile("" ::: "memory");
#pragma unroll
                for (int r = 0; r < RB; ++r) { const int m = m0 + r * NGW; if (m >= M) break;
                    const float ss = wave_sum(hp[r]);
                    float ax = 0.f;
#pragma unroll
                    for (int j = 0; j < NCH; ++j) ax = fmaxf(ax, fmaxf(fmaxf(fmaxf(fabsf(pg8::bf_lo(w[r][j].x)), fabsf(pg8::bf_hi(w[r][j].x))), fmaxf(fabsf(pg8::bf_lo(w[r][j].y)), fabsf(pg8::bf_hi(w[r][j].y)))),
                                                                           fmaxf(fmaxf(fabsf(pg8::bf_lo(w[r][j].z)), fabsf(pg8::bf_hi(w[r][j].z))), fmaxf(fabsf(pg8::bf_lo(w[r][j].w)), fabsf(pg8::bf_hi(w[r][j].w))))));
                    ax = wave_max(ax); ax = ax > 0.f ? ax : 1.0f; const float qi = 127.0f / ax;
                    if (lane == 0) { RS2[m] = 1.0f / sqrtf(ss * (1.0f / DM) + RMS_EPS); SAH[m] = ax * (1.0f / 127.0f); }
                    GAS unsigned long long* dst = (GAS unsigned long long*)(AQ + (size_t)m * (DM * 2)) + lane;
#pragma unroll
                    for (int j = 0; j < NCH; ++j) { const unsigned lo = q8pack4(pg8::bf_lo(w[r][j].x) * qi, pg8::bf_hi(w[r][j].x) * qi, pg8::bf_lo(w[r][j].y) * qi, pg8::bf_hi(w[r][j].y) * qi),
                                                                        hi2 = q8pack4(pg8::bf_lo(w[r][j].z) * qi, pg8::bf_hi(w[r][j].z) * qi, pg8::bf_lo(w[r][j].w) * qi, pg8::bf_hi(w[r][j].w) * qi);
                        if (512 * j + 8 * lane < KQ) dst[64 * j] = (unsigned long long)lo | ((unsigned long long)hi2 << 32); } }
            }
        }
        if (BOTH(7)) GRID_BAR();
    }

    if (IN(8)) {
        pg8::Gemm g{(const bf16*)AQ, (const bf16*)WGUX, M, NGU, PAGU / 2, DM, (const bf16*)((const char*)HB + KQ)}; pg8::StaticOrder S; S.init(M, NGU, G, bx);
        typedef pg8::EpiSwiGluT<T_GU8> EpiGU; EpiGU E{ACT, RS2, DFF, SAH, SBGU};
        pg8::gemm_phase<EpiGU, pg8::StaticOrder, true, true>(L + RING_OFF, g, S, E);
        {
            constexpr int NU = (M / 256) * (NGU / 256), ID = (DFF / 64) * (DM / 64); const int nshort = (NU % G) ? G - NU % G : G, first = (NU % G) ? NU % G : 0;
            if (bx >= first) { LANE_DECL; LAS unsigned char* scr = L + RING_OFF + wave * 16384;
                for (int it = (bx - first) * NWAVES + wave; it < ID; it += nshort * NWAVES) { const int nblk = DM / 64, kb = it / nblk, nb = it % nblk;
                    p0_tr_item(args.in[I_WDN], DM, 64 * nb, nullptr, WD, DFF, 64 * nb, 64 * kb, scr, lane); } }
        }
        if (BOTH(8)) GRID_BAR();
    }

    if (IN(9)) {
        pg8::Gemm g{ACT, WD, M, DM, DFF}; pg8::StaticOrder S; S.init(M, DM, G, bx, 2);
        typedef pg8::EpiResidP<true, true, false> EpiY;
        EpiY E{nullptr, HB, out, nullptr, nullptr, DM};
        pg8::gemm_phase<EpiY, pg8::StaticOrder, true, true>(L + RING_OFF, g, S, E);
    }
#undef IN
#undef BOTH
#undef tid
#undef LANE_DECL
}

extern "C" void kernel_launch(void* const* d_in, const int* in_sizes, int n_in, void* d_out, int out_size, void* d_ws, size_t ws_size, hipStream_t stream) {
    static int grid = 0;
    if (grid == 0) {
        if (n_in != N_IN || in_sizes[0] != M * DM || out_size != M * DM || ws_size < WS_END) { fprintf(stderr, "kernel_launch: shape/workspace mismatch (n_in %d, in0 %d, out %d, ws %zu, need %zu)\n", n_in, n_in > 0 ? in_sizes[0] : -1, out_size, ws_size, (size_t)WS_END); grid = -1; return; }
        int dev = 0, cus = 0, per_cu = 0;
        if (hipGetDevice(&dev) != hipSuccess || hipDeviceGetAttribute(&cus, hipDeviceAttributeMultiprocessorCount, dev) != hipSuccess) { grid = -1; return; }
        if (hipFuncSetAttribute((const void*)fwd, hipFuncAttributeMaxDynamicSharedMemorySize, LDS_BYTES) != hipSuccess) { fprintf(stderr, "kernel_launch: hipFuncSetAttribute failed\n"); grid = -1; return; }
        if (hipOccupancyMaxActiveBlocksPerMultiprocessor(&per_cu, (const void*)fwd, NWAVES * 64, LDS_BYTES) != hipSuccess || per_cu < 1) fprintf(stderr, "kernel_launch: occupancy query says %d\n", per_cu);
        (void)hipGetLastError();
        grid = cus;
    }
    if (grid < 0) return;
    if (hipMemsetAsync((char*)d_ws + WS_CTL, 0, CTL_ZERO_BYTES, stream) != hipSuccess) return;
    Args a{};
    for (int i = 0; i < N_IN; ++i) a.in[i] = (const float*)d_in[i];
    a.out = (float*)d_out; a.ws = (unsigned char*)d_ws;
    unsigned char* ws = (unsigned char*)d_ws;
    int li = 0;
#define LAUNCH(lo_, hi_) do { a.ph_lo = (lo_); a.ph_hi = (hi_); a.li = li++; hipLaunchKernelGGL(fwd, dim3(grid), dim3(NWAVES * 64), LDS_BYTES, stream, a); } while (0)
#if MK_ONE_LAUNCH
    LAUNCH(0, 10);
#if PROBE_DUP >= 0
    LAUNCH(PROBE_DUP, PROBE_DUP + 1);
#endif
#else
    LAUNCH(0, 1); LAUNCH(1, 2); LAUNCH(2, 3); LAUNCH(3, 4); LAUNCH(4, 5); LAUNCH(5, 6); LAUNCH(6, 7); LAUNCH(7, 8); LAUNCH(8, 9); LAUNCH(9, 10);
#endif
#undef LAUNCH
    const hipError_t le = hipPeekAtLastError();
    if (le != hipSuccess) fprintf(stderr, "kernel_launch: launch failed: %s\n", hipGetErrorName(le));
}
```
